# Optimizing an MI355X kernel written in HIP

```python
import math
import jax
import jax.numpy as jnp
from jax import lax
import numpy as np

D_MODEL = 2048
BATCH = 4
SEQ = 4096
DEPTH = 2

GRID_W = 64
CTX_LEN = 256
Q_BLOCK = 128
ROPE_BASE = 10000.0
NORM_EPS = 1e-6

DA_HEADS = 6
DA_DQK = 64
DA_DV = 2 * DA_DQK
DA_W = DA_HEADS * DA_DV

MLA_HEADS = 6
MLA_Q_RANK = 512
MLA_KV_RANK = 256
MLA_NOPE = 128
MLA_ROPE = 64
MLA_DV = 128
MLA_W = MLA_HEADS * MLA_DV

HY_CH = 512
HY_ORDER = 2
HY_EMB = 33
HY_BANDS = (HY_EMB - 1) // 2
HY_FFN = 64
HY_MIN_DECAY = math.log(1e-2) / 1.5
HY_MAX_DECAY = math.log(1e-2) / 0.3

D_FF = 5632
N_BRANCH = 3

IN_WIDTHS = (DA_HEADS * 2 * DA_DQK, DA_HEADS * 2 * DA_DQK, DA_W, MLA_Q_RANK, MLA_KV_RANK, MLA_ROPE, 3 * HY_CH, N_BRANCH * D_MODEL)
IN_OFFSETS = tuple(sum(IN_WIDTHS[: j + 1]) for j in range(len(IN_WIDTHS) - 1))
D_IN = sum(IN_WIDTHS)

DEEPNORM_ALPHA = (2 * DEPTH) ** 0.25
DEEPNORM_BETA = (8 * DEPTH) ** -0.25

kernel_name = "hybrid_diffusion_block"


def layer_norm(u, g=None, b=None):
    uf = u.astype(jnp.float32)
    mu = jnp.mean(uf, axis=-1, keepdims=True)
    var = jnp.mean(jnp.square(uf - mu), axis=-1, keepdims=True)
    y = ((uf - mu) * lax.rsqrt(var + NORM_EPS)).astype(u.dtype)
    return y if g is None else y * g + b


def rms_norm(u, g):
    uf = u.astype(jnp.float32)
    return (uf * lax.rsqrt(jnp.mean(uf * uf, axis=-1, keepdims=True) + NORM_EPS)).astype(u.dtype) * g


def modulate(u, shift, scale):
    return u * (1 + scale) + shift


def dwconv3(u, w, b):
    up = jnp.pad(u, ((0, 0), (1, 1), (0, 0)))
    return up[:, :-2] * w[0] + up[:, 1:-1] * w[1] + up[:, 2:] * w[2] + b


def rope_1d(u, pos):
    d = u.shape[-1]
    inv = ROPE_BASE ** (-jnp.arange(0, d, 2, dtype=jnp.float32) / d)
    ang = pos.astype(jnp.float32)[:, None] * inv[None, :]
    ang = jnp.concatenate([ang, ang], axis=-1).reshape((pos.shape[0],) + (1,) * (u.ndim - 3) + (d,))
    u1, u2 = jnp.split(u, 2, axis=-1)
    rot = jnp.concatenate([-u2, u1], axis=-1)
    return u * jnp.cos(ang).astype(u.dtype) + rot * jnp.sin(ang).astype(u.dtype)


def rope_2d(u, rows, cols):
    ur, uc = jnp.split(u, 2, axis=-1)
    return jnp.concatenate([rope_1d(ur, rows), rope_1d(uc, cols)], axis=-1)


def map_query_blocks(fn, *qs):
    b, n = qs[0].shape[:2]
    nb = n // Q_BLOCK
    blocks = tuple(jnp.moveaxis(q.reshape((b, nb, Q_BLOCK) + q.shape[2:]), 1, 0) for q in qs)
    out = lax.map(lambda qb: fn(*qb), blocks)
    return jnp.moveaxis(out, 0, 1).reshape((b, n) + out.shape[3:])


def diff_attend(q, k, v, lam):
    s = jnp.einsum('bqshd,bkshd->bshqk', q, k).astype(jnp.float32) * (DA_DQK ** -0.5)
    a = jax.nn.softmax(s, axis=-1)
    w = a[:, 0] - lam * a[:, 1]
    return jnp.einsum('bhqk,bkhe->bqhe', w.astype(v.dtype), v)


def mla_attend(q_nope, q_rope, k_nope, k_rope, v):
    s = jnp.einsum('bqhd,bkhd->bhqk', q_nope, k_nope) + jnp.einsum('bqhr,bkr->bhqk', q_rope, k_rope)
    a = jax.nn.softmax(s.astype(jnp.float32) * ((MLA_NOPE + MLA_ROPE) ** -0.5), axis=-1)
    return jnp.einsum('bhqk,bkhd->bqhd', a.astype(v.dtype), v)


def attn_queries(aq, bcq, q_g, w_uq, pos):
    b, n = aq.shape[:2]
    qa = aq.reshape(b, n, 2, DA_HEADS, DA_DQK)
    q = (rms_norm(bcq, q_g) @ w_uq).reshape(b, n, MLA_HEADS, MLA_NOPE + MLA_ROPE)
    qn, qr = q[..., :MLA_NOPE], q[..., MLA_NOPE:]
    if pos is not None:
        qa, qr = rope_2d(qa, *pos), rope_2d(qr, *pos)
    return qa, qn, qr


def attn_keys(ak, av, bckv, bkr, kv_g, w_ukv, pos):
    b, n = ak.shape[:2]
    ka = ak.reshape(b, n, 2, DA_HEADS, DA_DQK)
    va = av.reshape(b, n, DA_HEADS, DA_DV)
    kv = (rms_norm(bckv, kv_g) @ w_ukv).reshape(b, n, MLA_HEADS, MLA_NOPE + MLA_DV)
    kn, vb = kv[..., :MLA_NOPE], kv[..., MLA_NOPE:]
    kr = bkr
    if pos is not None:
        ka, kr = rope_2d(ka, *pos), rope_2d(kr, *pos)
    return ka, va, kn, kr, vb


def attend(queries, keys, lam, lam_init, subln_g):
    qa, qn, qr = queries
    ka, va, kn, kr, vb = keys
    b, n = qa.shape[:2]
    oa = map_query_blocks(lambda q: diff_attend(q, ka, va, lam), qa)
    oa = rms_norm(oa, subln_g) * (1 - lam_init)
    ob = map_query_blocks(lambda q1, q2: mla_attend(q1, q2, kn, kr, vb), qn, qr)
    return oa.reshape(b, n, DA_W), ob.reshape(b, n, MLA_W)


def hyena_filters(n, w1, b1, w2, b2, w3, b3, w4, freq):
    f32 = jnp.float32
    t = jnp.linspace(0.0, 1.0, n, dtype=f32)[:, None]
    phase = (2.0 * math.pi / n) * jnp.arange(n, dtype=f32)[:, None] * jnp.linspace(1e-4, HY_BANDS - 1, HY_BANDS, dtype=f32)[None, :]
    feat = jnp.concatenate([t, jnp.cos(phase), -jnp.sin(phase)], axis=-1)
    w = freq.astype(f32)
    h = jnp.sin(w * (feat @ w1.astype(f32) + b1.astype(f32)))
    h = jnp.sin(w * (h @ w2.astype(f32) + b2.astype(f32)))
    h = jnp.sin(w * (h @ w3.astype(f32) + b3.astype(f32)))
    h = (h @ w4.astype(f32)).reshape(n, HY_ORDER, 2, HY_CH)
    deltas = jnp.abs(jnp.linspace(HY_MIN_DECAY, HY_MAX_DECAY, HY_CH, dtype=f32))
    h = h * jnp.exp(-t.reshape(n, 1, 1, 1) * deltas)
    k = jnp.concatenate([h[:, :, 0], jnp.zeros((1, HY_ORDER, HY_CH), f32), h[: n - 1, :, 1][::-1]], axis=0)
    k = k / jnp.sum(jnp.abs(k), axis=0, keepdims=True)
    return jnp.fft.rfft(k, axis=0)


def hyena_branch(u, conv_w, conv_b, w1, b1, w2, b2, w3, b3, w4, freq, skip):
    n = u.shape[1]
    v, x1, x2 = jnp.split(dwconv3(u, conv_w, conv_b), 3, axis=-1)
    kf = hyena_filters(n, w1, b1, w2, b2, w3, b3, w4, freq)
    z = v.astype(jnp.float32)
    for o, gate in enumerate((x1, x2)):
        zf = jnp.fft.rfft(z, n=2 * n, axis=1)
        conv = jnp.fft.irfft(zf * kf[None, :, o], n=2 * n, axis=1)[:, :n]
        z = gate.astype(jnp.float32) * (conv + skip[o].astype(jnp.float32) * z)
    return z.astype(u.dtype)


def merge_branches(oa, ob, oc, gate_logits, w_ba, w_bb, w_bc, w_o):
    b, n = oa.shape[:2]
    g = jax.nn.sigmoid(gate_logits.reshape(b, n, N_BRANCH, D_MODEL))
    merged = g[..., 0, :] * (oa @ w_ba) + g[..., 1, :] * (ob @ w_bb) + g[..., 2, :] * (oc @ w_bc)
    return merged @ w_o


def conv_ffn(h, w_up, conv_w, conv_b, w_down):
    a, v = jnp.split(h @ w_up, 2, axis=-1)
    return (jax.nn.silu(dwconv3(a, conv_w, conv_b)) * v) @ w_down


def setup_inputs(seed: int = 0) -> dict:
    key = jax.random.key(seed)
    ks = iter(jax.random.split(key, 48))

    def nrm(shape, scale):
        return jax.random.normal(next(ks), shape, jnp.float32) * scale

    def gain(shape):
        return 1.0 + nrm(shape, 0.02)

    L, D = DEPTH, D_MODEL
    return {
        "x": nrm((BATCH, SEQ, D), 1.0),
        "c": nrm((BATCH, D), 1.0),
        "ctx": nrm((BATCH, CTX_LEN, D), 1.0),
        "c_ctx": nrm((D,), 1.0),
        "ada_w": nrm((L, D, 6 * D), D ** -0.5),
        "ada_b": nrm((L, 6 * D), 0.02),
        "w_in": nrm((L, D, D_IN), D ** -0.5),
        "da_lambda": nrm((L, 4, DA_DQK), 0.1),
        "da_subln_g": gain((L, DA_DV)),
        "mla_q_g": gain((L, MLA_Q_RANK)),
        "mla_w_uq": nrm((L, MLA_Q_RANK, MLA_HEADS * (MLA_NOPE + MLA_ROPE)), MLA_Q_RANK ** -0.5),
        "mla_kv_g": gain((L, MLA_KV_RANK)),
        "mla_w_ukv": nrm((L, MLA_KV_RANK, MLA_HEADS * (MLA_NOPE + MLA_DV)), MLA_KV_RANK ** -0.5),
        "hy_conv_w": nrm((L, 3, 3 * HY_CH), 3 ** -0.5),
        "hy_conv_b": nrm((L, 3 * HY_CH), 0.02),
        "hy_ffn_w1": nrm((L, HY_EMB, HY_FFN), HY_EMB ** -0.5),
        "hy_ffn_b1": nrm((L, HY_FFN), 0.02),
        "hy_ffn_w2": nrm((L, HY_FFN, HY_FFN), HY_FFN ** -0.5),
        "hy_ffn_b2": nrm((L, HY_FFN), 0.02),
        "hy_ffn_w3": nrm((L, HY_FFN, HY_FFN), HY_FFN ** -0.5),
        "hy_ffn_b3": nrm((L, HY_FFN), 0.02),
        "hy_ffn_w4": nrm((L, HY_FFN, HY_ORDER * 2 * HY_CH), HY_FFN ** -0.5),
        "hy_freq": gain((L, HY_FFN)),
        "hy_skip": nrm((L, HY_ORDER, HY_CH), 1.0),
        "w_branch_a": nrm((L, DA_W, D), DA_W ** -0.5),
        "w_branch_b": nrm((L, MLA_W, D), MLA_W ** -0.5),
        "w_branch_c": nrm((L, HY_CH, D), HY_CH ** -0.5),
        "w_out": nrm((L, D, D), D ** -0.5 * DEEPNORM_BETA),
        "ln1_g": gain((L, D)),
        "ln1_b": nrm((L, D), 0.02),
        "ffn_w_up": nrm((L, D, 2 * D_FF), D ** -0.5),
        "ffn_conv_w": nrm((L, 3, D_FF), 3 ** -0.5),
        "ffn_conv_b": nrm((L, D_FF), 0.02),
        "ffn_w_down": nrm((L, D_FF, D), D_FF ** -0.5 * DEEPNORM_BETA),
        "ln2_g": gain((L, D)),
        "ln2_b": nrm((L, D), 0.02),
    }


def reference(x, c, ctx, c_ctx, ada_w, ada_b, w_in, da_lambda, da_subln_g, mla_q_g, mla_w_uq, mla_kv_g, mla_w_ukv,
              hy_conv_w, hy_conv_b, hy_ffn_w1, hy_ffn_b1, hy_ffn_w2, hy_ffn_b2, hy_ffn_w3, hy_ffn_b3, hy_ffn_w4,
              hy_freq, hy_skip, w_branch_a, w_branch_b, w_branch_c, w_out, ln1_g, ln1_b,
              ffn_w_up, ffn_conv_w, ffn_conv_b, ffn_w_down, ln2_g, ln2_b):
    n_tok = x.shape[1]
    ROWS = n_tok // GRID_W
    rows = jnp.repeat(jnp.arange(ROWS, dtype=jnp.int32), GRID_W)
    cols = jnp.tile(jnp.arange(GRID_W, dtype=jnp.int32), ROWS)
    pos_lat = (rows, cols)

    def update_stream(xs, parts, pos, keys, mod, i, lam, lam_init):
        aq, bcq, cu, gate_logits = parts[0], parts[3], parts[6], parts[7]
        g1, sh2, sc2, g2 = mod[2], mod[3], mod[4], mod[5]
        oa, ob = attend(attn_queries(aq, bcq, mla_q_g[i], mla_w_uq[i], pos), keys, lam, lam_init, da_subln_g[i])
        oc = hyena_branch(cu, hy_conv_w[i], hy_conv_b[i], hy_ffn_w1[i], hy_ffn_b1[i], hy_ffn_w2[i], hy_ffn_b2[i],
                          hy_ffn_w3[i], hy_ffn_b3[i], hy_ffn_w4[i], hy_freq[i], hy_skip[i])
        y = merge_branches(oa, ob, oc, gate_logits, w_branch_a[i], w_branch_b[i], w_branch_c[i], w_out[i])
        xs = layer_norm(DEEPNORM_ALPHA * xs + g1 * y, ln1_g[i], ln1_b[i])
        y = conv_ffn(modulate(layer_norm(xs), sh2, sc2), ffn_w_up[i], ffn_conv_w[i], ffn_conv_b[i], ffn_w_down[i])
        return layer_norm(DEEPNORM_ALPHA * xs + g2 * y, ln2_g[i], ln2_b[i])

    xl, xc = x, ctx
    for i in range(DEPTH):
        lam_init = 0.8 - 0.6 * math.exp(-0.3 * i)
        lq1, lk1, lq2, lk2 = da_lambda[i].astype(jnp.float32)
        lam = jnp.exp(jnp.sum(lq1 * lk1)) - jnp.exp(jnp.sum(lq2 * lk2)) + lam_init
        mod_l = jnp.split((jax.nn.silu(c) @ ada_w[i] + ada_b[i])[:, None, :], 6, axis=-1)
        mod_c = jnp.split((jax.nn.silu(c_ctx) @ ada_w[i] + ada_b[i])[None, None, :], 6, axis=-1)
        parts_l = jnp.split(modulate(layer_norm(xl), mod_l[0], mod_l[1]) @ w_in[i], IN_OFFSETS, axis=-1)
        parts_c = jnp.split(modulate(layer_norm(xc), mod_c[0], mod_c[1]) @ w_in[i], IN_OFFSETS, axis=-1)
        keys_c = attn_keys(parts_c[1], parts_c[2], parts_c[4], parts_c[5], mla_kv_g[i], mla_w_ukv[i], None)
        keys_l = attn_keys(parts_l[1], parts_l[2], parts_l[4], parts_l[5], mla_kv_g[i], mla_w_ukv[i], pos_lat)
        keys_all = tuple(jnp.concatenate([kc, kl], axis=1) for kc, kl in zip(keys_c, keys_l))
        new_xl = update_stream(xl, parts_l, pos_lat, keys_all, mod_l, i, lam, lam_init)
        if i < DEPTH - 1:
            xc = update_stream(xc, parts_c, None, keys_c, mod_c, i, lam, lam_init)
        xl = new_xl
    return xl
```

```cpp
#include <hip/hip_runtime.h>
#include <hip/hip_cooperative_groups.h>
#include <cstdio>
#include <cstdint>
namespace cg = cooperative_groups;

#define LAS __attribute__((address_space(3)))
#define DI __device__ __forceinline__
typedef unsigned short bf16_t;
typedef short bf16x8 __attribute__((ext_vector_type(8)));
typedef float f32x2 __attribute__((ext_vector_type(2)));
typedef float f32x4 __attribute__((ext_vector_type(4)));
typedef float f32x16 __attribute__((ext_vector_type(16)));
typedef unsigned u32x2 __attribute__((ext_vector_type(2)));
typedef unsigned u32x4 __attribute__((ext_vector_type(4)));
typedef __bf16 bf16x2_t __attribute__((ext_vector_type(2)));

DI unsigned pk2(float lo, float hi) { f32x2 v = {lo, hi}; bf16x2_t b = __builtin_convertvector(v, bf16x2_t); return __builtin_bit_cast(unsigned, b); }
DI bf16_t f2bf(float f) { return (bf16_t)(pk2(f, 0.f) & 0xffffu); }
DI float bf2f(bf16_t h) { return __uint_as_float(((unsigned)h) << 16); }
DI float bflo(unsigned w) { return __uint_as_float(w << 16); }
DI float bfhi(unsigned w) { return __uint_as_float(w & 0xffff0000u); }
template <int M> DI float swz(float v) { return __int_as_float(__builtin_amdgcn_ds_swizzle(__float_as_int(v), (M << 10) | 0x1f)); }
DI float half_sum(float v) { auto rr = __builtin_amdgcn_permlane32_swap(__float_as_uint(v), __float_as_uint(v), false, false); return __uint_as_float(rr[0]) + __uint_as_float(rr[1]); }
DI float half_max(float v) { auto rr = __builtin_amdgcn_permlane32_swap(__float_as_uint(v), __float_as_uint(v), false, false); return fmaxf(__uint_as_float(rr[0]), __uint_as_float(rr[1])); }
DI float sum32(float v) { v += swz<1>(v); v += swz<2>(v); v += swz<4>(v); v += swz<8>(v); v += swz<16>(v); return v; }
DI float wave_sum(float v) { return half_sum(sum32(v)); }
#define LDS_WAIT() asm volatile("s_waitcnt lgkmcnt(0)" ::: "memory")
DI int lane_id() { int l; asm volatile("v_mbcnt_lo_u32_b32 %0, -1, 0\n\tv_mbcnt_hi_u32_b32 %0, -1, %0" : "=v"(l)); return l; }
DI int wave_id() { return __builtin_amdgcn_readfirstlane((int)threadIdx.x >> 6); }
DI int tid_fresh(int wid_s) { int t = wid_s * 64 + lane_id(); asm volatile("" : "+v"(t)); return t; }

constexpr int D = 2048, NBATCH = 4, SEQ = 4096, CTXL = 256, ML = 16384, MC = 1024, MT = 17408, NKEY = 4352, DFF = 5632;
constexpr int NWIN = 8704, NWINT = 2304, NUQ = 1280;
constexpr float EPS = 1e-6f;
constexpr float ALPHA = 1.41421356237f;
constexpr float LOG2E = 1.4426950408889634f;
constexpr float QS_DA = 0.125f * LOG2E;
constexpr float QS_MLA = 0.07216878364870322f * LOG2E;

constexpr size_t al(size_t x) { return (x + 255) & ~(size_t)255; }
constexpr size_t O_MOD = 0;
constexpr size_t O_LAM = al(O_MOD + (size_t)2 * 5 * 12288 * 4);
constexpr size_t O_ROPE = O_LAM + 256;
constexpr size_t O_HSUM = al(O_ROPE + 64 * 16 * 8);
constexpr size_t O_BAR = al(O_HSUM + 3 * 2048 * 4);
constexpr size_t O_PQ = al(O_BAR + 16384);
constexpr size_t O_PKV = al(O_PQ + (size_t)MT * 8 * 4);
constexpr size_t O_ST1 = al(O_PKV + (size_t)MT * 4 * 4);
constexpr size_t O_ST2 = O_ST1 + (size_t)ML * 8;
constexpr size_t O_FILT0 = al(O_ST2 + (size_t)ML * 8);
constexpr size_t FILT_SZ = (size_t)2 * 512 * 8192 * 2;
constexpr size_t O_FILT1 = O_FILT0 + FILT_SZ;
constexpr size_t O_FILTC = O_FILT1 + FILT_SZ;
constexpr size_t O_XC = al(O_FILTC + (size_t)2 * 512 * 512 * 2);
constexpr size_t O_WIN = al(O_XC + (size_t)MC * D * 4);
constexpr size_t O_WINT = O_WIN + (size_t)NWIN * D * 2;
constexpr size_t O_WUQ = O_WINT + (size_t)NWINT * D * 2;
constexpr size_t O_WUKV = O_WUQ + (size_t)NUQ * 512 * 2;
constexpr size_t O_WUKVT = O_WUKV + (size_t)768 * 256 * 2;
constexpr size_t O_WBA = O_WUKVT + (size_t)768 * 256 * 2;
constexpr size_t O_WBB = O_WBA + (size_t)2048 * 768 * 2;
constexpr size_t O_WBC = O_WBB + (size_t)2048 * 768 * 2;
constexpr size_t O_WOUT = O_WBC + (size_t)2048 * 512 * 2;
constexpr size_t O_WUP = O_WOUT + (size_t)2048 * 2048 * 2;
constexpr size_t O_WDN = O_WUP + (size_t)11264 * 2048 * 2;
constexpr size_t O_R = al(O_WDN + (size_t)2048 * 5632 * 2);
constexpr size_t O_QDA = O_R;
constexpr size_t O_KDA = O_QDA + (size_t)MT * 768 * 2;
constexpr size_t O_VDAT = O_KDA + (size_t)MT * 768 * 2;
constexpr size_t O_QLAT = O_VDAT + (size_t)4 * 768 * NKEY * 2;
constexpr size_t O_KVLAT = O_QLAT + (size_t)MT * 512 * 2;
constexpr size_t O_HYT = O_KVLAT + (size_t)MT * 256 * 2;
constexpr size_t O_HYTC = O_HYT + (size_t)4 * 1536 * 4096 * 2;
constexpr size_t O_G = O_HYTC + (size_t)4 * 1536 * 256 * 2;
constexpr size_t O_KR = O_G + (size_t)MT * 6144 * 2;
constexpr size_t O_REND = O_KR + (size_t)MT * 64 * 2;
constexpr size_t O_HTMP = O_R;
constexpr size_t O_HH = O_R;
constexpr size_t O_SA = O_HH + (size_t)MT * DFF * 2;
constexpr size_t O_SV = O_SA + (size_t)(MT / 16) * DFF * 2;
static_assert(O_SV + (size_t)(MT / 32) * DFF * 2 <= O_REND, "FFN overlay");
static_assert(O_HTMP + (size_t)(2 * 4096 + 256) * 2048 * 4 <= O_REND, "H overlay");
constexpr size_t O_A = al(O_REND);
constexpr size_t O_QM = O_A + (size_t)MT * 2048 * 2;
constexpr size_t O_KN = O_QM + (size_t)MT * 1152 * 2;
constexpr size_t O_VBT = O_KN + (size_t)MT * 768 * 2;
constexpr size_t O_OA = O_VBT + (size_t)4 * 768 * NKEY * 2;
constexpr size_t O_OB = O_OA + (size_t)MT * 768 * 2;
constexpr size_t O_OC = O_OB + (size_t)MT * 768 * 2;
constexpr size_t WS_END = O_OC + (size_t)MT * 512 * 2;
constexpr size_t ZERO_BYTES = O_PQ;

constexpr int LDS_BYTES = 155648;

struct Args { const float* in[36]; float* out; unsigned char* ws; };
enum { I_X = 0, I_C, I_CTX, I_CCTX, I_ADAW, I_ADAB, I_WIN, I_LAMBDA, I_SUBG, I_QG, I_WUQ, I_KVG, I_WUKV, I_HCW, I_HCB, I_HW1, I_HB1, I_HW2, I_HB2,
       I_HW3, I_HB3, I_HW4, I_HFREQ, I_HSKIP, I_WBA, I_WBB, I_WBC, I_WOUT, I_LN1G, I_LN1B, I_WUP, I_FCW, I_FCB, I_WDN, I_LN2G, I_LN2B };

typedef const float* cfp_t;
DI cfp_t ARG(int i) { const __attribute__((address_space(4))) cfp_t* p = (const __attribute__((address_space(4))) cfp_t*)__builtin_amdgcn_kernarg_segment_ptr(); asm volatile("" : "+s"(p)); return p[i]; }
#define AOUT() ((float*)ARG(36))
#define WSP() ((unsigned char*)ARG(37))

namespace pg8 {
constexpr int BM = 256, BK = 64, HALF = 128, HTB = HALF * BK * 2, NXCD = 8, WGM = 8;
__host__ __device__ __forceinline__ int lds_byte(int r, int c) { const int st = (r >> 4) * 2 + (c >> 5), rr = r & 15, cc = c & 31, ob = rr * 64 + cc * 2; return st * 1024 + (ob ^ (((ob >> 9) & 1) << 5)); }
__host__ __device__ __forceinline__ void stage_rc(int b, int& R, int& C) { const int st = b / 1024, sb = b % 1024, swz = sb ^ (((sb >> 9) & 1) << 5); R = (st >> 1) * 16 + swz / 64; C = (st & 1) * 32 + (swz % 64) / 2; }
__host__ __device__ __forceinline__ int perm32(int rho) { const int n = rho >> 4, i = rho & 15; return 8 * (i >> 2) + 4 * n + (i & 3); }
struct Unit { int pm, pn; };
struct Gemm { const bf16_t* A; const bf16_t* Bt; int M, N, K; int ld = 0; };
struct StaticOrder {
    int nM, nN, nwg, G, c;
    __device__ void init(int M, int N, int G_, int c_) { nM = M / BM; nN = N / BM; nwg = nM * nN; G = G_; c = c_; }
    __device__ bool next(int i, Unit& u) const {
        const long L = (long)i * G + c; if (L >= nwg) return false;
        int wgid = (int)L; { const int q = nwg / NXCD, r = nwg % NXCD, xcd = wgid % NXCD, off = wgid / NXCD; wgid = (xcd < r ? xcd * (q + 1) : r * (q + 1) + (xcd - r) * q) + off; }
        const int nig = WGM * nN, gid = wgid / nig, fm = gid * WGM, gsz = (nM - fm) < WGM ? (nM - fm) : WGM;
        u.pm = fm + ((wgid % nig) % gsz); u.pn = (wgid % nig) / gsz; return true;
    }
};
template <class Epi, bool TRANSOUT>
__device__ __forceinline__ void gemm_phase(LAS unsigned char* lds, const Gemm g, int G, int cidx, const Epi& E, int wid_s) {
    const int tid_ = tid_fresh(wid_s);
    const int tid = tid_, wid = __builtin_amdgcn_readfirstlane(tid >> 6), lane = tid & 63, wr = wid >> 2, wc = wid & 3, fr = lane & 15, fq = lane >> 4;
    const int K = g.K, nt = K / BK, LD = g.ld ? g.ld : g.K;
    int G_ = G, cidx_ = cidx; asm volatile("" : "+s"(G_), "+s"(cidx_));
    StaticOrder S; S.init(g.M, g.N, G_, cidx_);
    unsigned voffA[2], voffB[2];
#pragma unroll
    for (int i = 0; i < 2; ++i) { int R, C; stage_rc(tid * 16 + i * 8192, R, C); const int Rb = Epi::PERM ? ((R & ~31) + perm32(R & 31)) : R;
        voffA[i] = (unsigned)(R * LD + C) * 2u; voffB[i] = (unsigned)(Rb * LD + C) * 2u; }
    const size_t kstep = (size_t)(BK * 2);
    const size_t hstep = (size_t)HALF * LD * 2;
    const size_t tstep = 2 * hstep;
    const unsigned ldsw = (unsigned)wid * 1024u;
    const int aoff = lds_byte(wr * 64 + fr, fq * 8), boff = lds_byte(wc * 32 + fr, fq * 8);
#define PG8_SA(b, h) (((b) * 2 + (h)) * HTB)
#define PG8_SB(b, h) ((4 + (b) * 2 + (h)) * HTB)
#define PG8_STAGE(bufoff, gbase, voff) do { _Pragma("unroll") for (int _i = 0; _i < 2; ++_i) \
        __builtin_amdgcn_global_load_lds((const unsigned*)((const char*)(gbase) + (voff)[_i]), (LAS unsigned*)(lds + (bufoff) + ldsw + _i * 8192), 16, 0, 0); } while (0)
#define PG8_LDA(dst, b, h) do { _Pragma("unroll") for (int m = 0; m < 4; ++m) _Pragma("unroll") for (int k = 0; k < 2; ++k) dst[m][k] = *(const LAS bf16x8*)(lds + PG8_SA(b, h) + aoff + m * 2048 + k * 1024); } while (0)
#define PG8_LDB(dst, b, h) do { _Pragma("unroll") for (int n = 0; n < 2; ++n) _Pragma("unroll") for (int k = 0; k < 2; ++k) dst[n][k] = *(const LAS bf16x8*)(lds + PG8_SB(b, h) + boff + n * 2048 + k * 1024); } while (0)
#define PG8_MMA(ai, bj, At, Bt) do { __builtin_amdgcn_s_setprio(1); _Pragma("unroll") for (int m = 0; m < 4; ++m) _Pragma("unroll") for (int n = 0; n < 2; ++n) _Pragma("unroll") for (int k = 0; k < 2; ++k) \
        acc[ai][bj][m][n] = TRANSOUT ? __builtin_amdgcn_mfma_f32_16x16x32_bf16(At[m][k], Bt[n][k], acc[ai][bj][m][n], 0, 0, 0) \
                                     : __builtin_amdgcn_mfma_f32_16x16x32_bf16(Bt[n][k], At[m][k], acc[ai][bj][m][n], 0, 0, 0); __builtin_amdgcn_s_setprio(0); } while (0)
#define PG8_WAIT_V(n) asm volatile("s_waitcnt vmcnt(" #n ")" ::: "memory")
#define PG8_WAIT_L(n) asm volatile("s_waitcnt lgkmcnt(" #n ")" ::: "memory")
#define PG8_BAR __builtin_amdgcn_s_barrier()
#define PG8_SCHED __builtin_amdgcn_sched_barrier(0)
    Unit cur, nxt; int ui = 0;
    if (!S.next(0, cur)) return;
    f32x4 acc[2][2][4][2];
#pragma unroll
    for (int a = 0; a < 2; ++a)
#pragma unroll
        for (int b = 0; b < 2; ++b)
#pragma unroll
            for (int m = 0; m < 4; ++m)
#pragma unroll
                for (int n = 0; n < 2; ++n) acc[a][b][m][n] = (f32x4){0.f, 0.f, 0.f, 0.f};
    bf16x8 At[4][2], B0[2][2], B1[2][2];
    const char* cA = (const char*)g.A + (size_t)cur.pm * tstep; const char* cB = (const char*)g.Bt + (size_t)cur.pn * tstep;
    PG8_STAGE(PG8_SB(0, 0), cB, voffB); PG8_STAGE(PG8_SB(0, 1), cB + hstep, voffB); PG8_STAGE(PG8_SA(0, 0), cA, voffA); PG8_STAGE(PG8_SA(0, 1), cA + hstep, voffA);
    if (wr == 1) PG8_BAR;
    PG8_WAIT_V(2); PG8_BAR;
    PG8_STAGE(PG8_SB(1, 0), cB + kstep, voffB); PG8_STAGE(PG8_SA(1, 0), cA + kstep, voffA); PG8_STAGE(PG8_SB(1, 1), cB + hstep + kstep, voffB);
    PG8_WAIT_V(6); PG8_BAR;
    for (;;) {
        const bool has_next = S.next(ui + 1, nxt);
        const char* nA = has_next ? (const char*)g.A + (size_t)nxt.pm * tstep : cA; const char* nB = has_next ? (const char*)g.Bt + (size_t)nxt.pn * tstep : cB;
        for (int t = 0; t < nt; t += 2) {
            if constexpr (Epi::HOOK) { if (t == 12 || t == 24) { int fr_ = fr, fq_ = fq; asm volatile("" : "+v"(fr_), "+v"(fq_)); E.hook(acc, cur, t, wr, wc, fr_, fq_); } }
            const bool last = (t == nt - 2);
            const char* a1 = cA + (size_t)(t + 1) * kstep;
            const char* a2 = last ? nA : cA + (size_t)(t + 2) * kstep; const char* b2 = last ? nB : cB + (size_t)(t + 2) * kstep;
            const char* a3 = a2 + kstep; const char* b3 = b2 + kstep;
            PG8_LDB(B0, 0, 0); PG8_LDB(B1, 0, 1); PG8_SCHED; PG8_LDA(At, 0, 0); PG8_STAGE(PG8_SA(1, 1), a1 + hstep, voffA);
            PG8_WAIT_V(8); PG8_WAIT_L(0); PG8_BAR; PG8_MMA(0, 0, At, B0); PG8_MMA(0, 1, At, B1); PG8_BAR; PG8_SCHED;
            PG8_LDA(At, 0, 1); PG8_STAGE(PG8_SB(0, 0), b2, voffB); PG8_STAGE(PG8_SB(0, 1), b2 + hstep, voffB); PG8_STAGE(PG8_SA(0, 0), a2, voffA);
            PG8_WAIT_V(8); PG8_WAIT_L(0); PG8_BAR; PG8_MMA(1, 0, At, B0); PG8_MMA(1, 1, At, B1); PG8_BAR; PG8_SCHED;
            PG8_LDB(B0, 1, 0); PG8_LDB(B1, 1, 1); PG8_SCHED; PG8_LDA(At, 1, 0); PG8_STAGE(PG8_SA(0, 1), a2 + hstep, voffA);
            PG8_WAIT_V(8); PG8_WAIT_L(0); PG8_BAR; PG8_MMA(0, 0, At, B0); PG8_MMA(0, 1, At, B1); PG8_BAR; PG8_SCHED;
            PG8_LDA(At, 1, 1); PG8_STAGE(PG8_SB(1, 0), b3, voffB); PG8_STAGE(PG8_SB(1, 1), b3 + hstep, voffB); PG8_STAGE(PG8_SA(1, 0), a3, voffA);
            PG8_WAIT_V(8); PG8_WAIT_L(0); PG8_BAR; PG8_MMA(1, 0, At, B0); PG8_MMA(1, 1, At, B1); PG8_BAR; PG8_SCHED;
        }
        if (wr == 0) PG8_BAR;
        { int fr_ = fr, fq_ = fq, wr_ = wr, wc_ = wc; asm volatile("" : "+v"(fr_), "+v"(fq_), "+s"(wr_), "+s"(wc_));
          E(acc, cur, wr_, wc_, fr_, fq_); }
        if (!has_next) break;
#pragma unroll
        for (int a = 0; a < 2; ++a)
#pragma unroll
            for (int b = 0; b < 2; ++b)
#pragma unroll
                for (int m = 0; m < 4; ++m)
#pragma unroll
                    for (int n = 0; n < 2; ++n) acc[a][b][m][n] = (f32x4){0.f, 0.f, 0.f, 0.f};
        cur = nxt; cA = nA; cB = nB; ++ui;
        if (wr == 1) PG8_BAR;
    }
    PG8_WAIT_V(0);
    PG8_BAR;
#undef PG8_SA
#undef PG8_SB
#undef PG8_STAGE
#undef PG8_LDA
#undef PG8_LDB
#undef PG8_MMA
#undef PG8_WAIT_V
#undef PG8_WAIT_L
#undef PG8_BAR
#undef PG8_SCHED
}
}
using pg8::Unit;
typedef f32x4 Acc[2][2][4][2];

DI void rope8(f32x4& v0, f32x4& v1, const f32x2* rp) {
    const f32x4 c01 = *(const f32x4*)rp, c23 = *(const f32x4*)(rp + 2);
    float a, b;
    a = v0[0]; b = v0[1]; v0[0] = a * c01[0] - b * c01[1]; v0[1] = b * c01[0] + a * c01[1];
    a = v0[2]; b = v0[3]; v0[2] = a * c01[2] - b * c01[3]; v0[3] = b * c01[2] + a * c01[3];
    a = v1[0]; b = v1[1]; v1[0] = a * c23[0] - b * c23[1]; v1[1] = b * c23[0] + a * c23[1];
    a = v1[2]; b = v1[3]; v1[2] = a * c23[2] - b * c23[3]; v1[3] = b * c23[2] + a * c23[3];
}
DI u32x4 pack8(const f32x4& v0, const f32x4& v1) { u32x4 w; w.x = pk2(v0[0], v0[1]); w.y = pk2(v0[2], v0[3]); w.z = pk2(v1[0], v1[1]); w.w = pk2(v1[2], v1[3]); return w; }
DI float sigm(float x) { return __builtin_amdgcn_rcpf(1.f + __expf(-x)); }
DI float sigm_pos(float x) { return fmaxf(sigm(x), 1e-30f); }

struct EpiWin {
    static constexpr bool PERM = true, HOOK = false;
    bf16_t *qda, *kda, *qlat, *kvlat, *g, *kr; float *pq, *pkv; const f32x2* rope; int pmoff, pnoff;
    DI void operator()(const Acc& acc, const Unit& u, int wr, int wc, int fr, int fq) const {
        const int pn = u.pn + pnoff, pm = u.pm + pmoff; const int row0 = pm * 256 + wr * 64 + fr; const int cw = wc * 32 + fq * 8; const bool latent = pm < 64;
        if (pn < 6 || pn == 33) {
            if (pn == 33 && wc >= 2) return;
            bf16_t* dst; int ld, colb; float sc;
            if (pn < 3) { dst = qda; ld = 768; colb = pn * 256; sc = QS_DA; } else if (pn < 6) { dst = kda; ld = 768; colb = (pn - 3) * 256; sc = 1.f; } else { dst = kr; ld = 64; colb = 0; sc = 1.f; }
            const int half = wc & 1, jj0 = 4 * fq;
#pragma unroll
            for (int ai = 0; ai < 2; ++ai)
#pragma unroll
                for (int m = 0; m < 4; ++m) {
                    const int row = row0 + ai * 128 + m * 16; const int t = row & 4095; const int pos = half ? (t & 63) : (t >> 6);
                    const f32x2* rp = rope + pos * 16 + jj0;
#pragma unroll
                    for (int bj = 0; bj < 2; ++bj) {
                        if (pn == 33 && bj == 1) continue;
                        f32x4 v0 = acc[ai][bj][m][0], v1 = acc[ai][bj][m][1];
                        if (latent) rope8(v0, v1, rp);
                        v0 = v0 * sc; v1 = v1 * sc;
                        *(u32x4*)(dst + (size_t)row * ld + colb + bj * 128 + cw) = pack8(v0, v1);
                    }
                }
        } else if (pn < 9) {
            bf16_t* dst; int ld, colb; float* pp; int pst, pof;
            if (pn < 8) { dst = qlat; ld = 512; colb = (pn - 6) * 256; pp = pq; pst = 8; pof = (pn - 6) * 4 + wc; } else { dst = kvlat; ld = 256; colb = 0; pp = pkv; pst = 4; pof = wc; }
#pragma unroll
            for (int ai = 0; ai < 2; ++ai)
#pragma unroll
                for (int m = 0; m < 4; ++m) {
                    const int row = row0 + ai * 128 + m * 16; float s = 0.f;
#pragma unroll
                    for (int bj = 0; bj < 2; ++bj) {
                        const f32x4 v0 = acc[ai][bj][m][0], v1 = acc[ai][bj][m][1];
                        s += (v0[0] * v0[0] + v0[1] * v0[1]) + (v0[2] * v0[2] + v0[3] * v0[3]) + (v1[0] * v1[0] + v1[1] * v1[1]) + (v1[2] * v1[2] + v1[3] * v1[3]);
                        *(u32x4*)(dst + (size_t)row * ld + colb + bj * 128 + cw) = pack8(v0, v1);
                    }
                    s += swz<16>(s); s = half_sum(s);
                    if (fq == 0) pp[(size_t)row * pst + pof] = s;
                }
        } else {
            const int colb = (pn - 9) * 256;
#pragma unroll
            for (int ai = 0; ai < 2; ++ai)
#pragma unroll
                for (int m = 0; m < 4; ++m) {
                    const int row = row0 + ai * 128 + m * 16;
#pragma unroll
                    for (int bj = 0; bj < 2; ++bj) {
                        f32x4 v0 = acc[ai][bj][m][0], v1 = acc[ai][bj][m][1];
#pragma unroll
                        for (int e = 0; e < 4; ++e) { v0[e] = sigm_pos(v0[e]); v1[e] = sigm_pos(v1[e]); }
                        *(u32x4*)(g + (size_t)row * 6144 + colb + bj * 128 + cw) = pack8(v0, v1);
                    }
                }
        }
    }
};
struct EpiWinT {
    static constexpr bool PERM = false, HOOK = false;
    bf16_t *vdat, *hyt, *hytc; int pmoff;
    DI void operator()(const Acc& acc, const Unit& u, int wr, int wc, int fr, int fq) const {
        const int pm = u.pm + pmoff; const bool latent = pm < 64;
#pragma unroll
        for (int ai = 0; ai < 2; ++ai)
#pragma unroll
            for (int m = 0; m < 4; ++m) {
                const int row = pm * 256 + ai * 128 + wr * 64 + m * 16 + fq * 4;
                const int b = latent ? (row >> 12) : ((row - ML) >> 8); const int t = latent ? (row & 4095) : ((row - ML) & 255);
#pragma unroll
                for (int bj = 0; bj < 2; ++bj)
#pragma unroll
                    for (int n = 0; n < 2; ++n) {
                        const int col = u.pn * 256 + bj * 128 + wc * 32 + n * 16 + fr; const f32x4 v = acc[ai][bj][m][n];
                        bf16_t* dst;
                        if (col < 768) dst = vdat + ((size_t)(b * 768 + col) * NKEY + (latent ? 256 + t : t));
                        else dst = latent ? hyt + ((size_t)(b * 1536 + col - 768) * 4096 + t) : hytc + ((size_t)(b * 1536 + col - 768) * 256 + t);
                        u32x2 w; w.x = pk2(v[0], v[1]); w.y = pk2(v[2], v[3]); *(u32x2*)dst = w;
                    }
            }
    }
};
DI float rstd_from(const float* p, int n, float inv) { float s = 0.f; for (int i = 0; i < n; ++i) s += p[i]; return 1.0f / sqrtf(s * inv + EPS); }
struct EpiUq {
    static constexpr bool PERM = true, HOOK = false;
    bf16_t* qm; const float* pq; const f32x2* rope;
    DI void operator()(const Acc& acc, const Unit& u, int wr, int wc, int fr, int fq) const {
        const int row0 = u.pm * 256 + wr * 64 + fr; const bool latent = u.pm < 64;
#pragma unroll
        for (int ai = 0; ai < 2; ++ai)
#pragma unroll
            for (int m = 0; m < 4; ++m) {
                const int row = row0 + ai * 128 + m * 16; const int t = row & 4095;
                const f32x4 q0 = *(const f32x4*)(pq + (size_t)row * 8), q1 = *(const f32x4*)(pq + (size_t)row * 8 + 4);
                const float rs = QS_MLA / sqrtf(((q0[0] + q0[1]) + (q0[2] + q0[3]) + (q1[0] + q1[1]) + (q1[2] + q1[3])) * (1.f / 512.f) + EPS);
#pragma unroll
                for (int bj = 0; bj < 2; ++bj) {
                    const int col = u.pn * 256 + bj * 128 + wc * 32 + fq * 8;
                    if (col >= 1152) continue;
                    const int dd = col % 192;
                    f32x4 v0 = acc[ai][bj][m][0] * rs, v1 = acc[ai][bj][m][1] * rs;
                    if (dd >= 128 && latent) { const int pp = dd - 128; const int pos = (pp >> 5) ? (t & 63) : (t >> 6); rope8(v0, v1, rope + pos * 16 + ((pp & 31) >> 1)); }
                    *(u32x4*)(qm + (size_t)row * 1152 + col) = pack8(v0, v1);
                }
            }
    }
};
struct EpiUkv {
    static constexpr bool PERM = true, HOOK = false;
    bf16_t* kn; const float* pkv;
    DI void operator()(const Acc& acc, const Unit& u, int wr, int wc, int fr, int fq) const {
        const int row0 = u.pm * 256 + wr * 64 + fr;
#pragma unroll
        for (int ai = 0; ai < 2; ++ai)
#pragma unroll
            for (int m = 0; m < 4; ++m) {
                const int row = row0 + ai * 128 + m * 16;
                const f32x4 q0 = *(const f32x4*)(pkv + (size_t)row * 4);
                const float rs = 1.0f / sqrtf(((q0[0] + q0[1]) + (q0[2] + q0[3])) * (1.f / 256.f) + EPS);
#pragma unroll
                for (int bj = 0; bj < 2; ++bj) {
                    const int col = u.pn * 256 + bj * 128 + wc * 32 + fq * 8;
                    *(u32x4*)(kn + (size_t)row * 768 + col) = pack8(acc[ai][bj][m][0] * rs, acc[ai][bj][m][1] * rs);
                }
            }
    }
};
struct EpiUkvT {
    static constexpr bool PERM = false, HOOK = false;
    bf16_t* vbt; const float* pkv;
    DI void operator()(const Acc& acc, const Unit& u, int wr, int wc, int fr, int fq) const {
        const bool latent = u.pm < 64;
#pragma unroll
        for (int ai = 0; ai < 2; ++ai)
#pragma unroll
            for (int m = 0; m < 4; ++m) {
                const int row = u.pm * 256 + ai * 128 + wr * 64 + m * 16 + fq * 4;
                const int b = latent ? (row >> 12) : ((row - ML) >> 8); const int key = latent ? 256 + (row & 4095) : ((row - ML) & 255);
                float rs[4];
#pragma unroll
                for (int j = 0; j < 4; ++j) { const f32x4 q0 = *(const f32x4*)(pkv + (size_t)(row + j) * 4); rs[j] = 1.0f / sqrtf(((q0[0] + q0[1]) + (q0[2] + q0[3])) * (1.f / 256.f) + EPS); }
#pragma unroll
                for (int bj = 0; bj < 2; ++bj)
#pragma unroll
                    for (int n = 0; n < 2; ++n) {
                        const int col = u.pn * 256 + bj * 128 + wc * 32 + n * 16 + fr; const f32x4 v = acc[ai][bj][m][n];
                        u32x2 w; w.x = pk2(v[0] * rs[0], v[1] * rs[1]); w.y = pk2(v[2] * rs[2], v[3] * rs[3]);
                        *(u32x2*)(vbt + ((size_t)(b * 768 + col) * NKEY + key)) = w;
                    }
            }
    }
};
struct EpiMerge {
    static constexpr bool PERM = true, HOOK = true;
    const bf16_t* g; bf16_t* o;
    DI void hook(Acc& acc, const Unit& u, int t, int wr, int wc, int fr, int fq) const {
        const int jp = (t == 12) ? 0 : 2048; const int row0 = u.pm * 256 + wr * 64 + fr;
#pragma unroll
        for (int ai = 0; ai < 2; ++ai)
#pragma unroll
            for (int m = 0; m < 4; ++m) {
#pragma unroll
                for (int bj = 0; bj < 2; ++bj) {
                    const bf16_t* p = g + (size_t)(row0 + ai * 128 + m * 16) * 6144 + jp + u.pn * 256 + bj * 128 + wc * 32 + fq * 8;
                    const u32x4 gp = *(const u32x4*)p, gn = *(const u32x4*)(p + 2048);
#pragma unroll
                    for (int e = 0; e < 4; ++e) {
                        const unsigned a_ = gp[e], b_ = gn[e];
                        const float r0 = bflo(a_) * __builtin_amdgcn_rcpf(bflo(b_)), r1 = bfhi(a_) * __builtin_amdgcn_rcpf(bfhi(b_));
                        if (e < 2) { acc[ai][bj][m][0][2 * e] *= r0; acc[ai][bj][m][0][2 * e + 1] *= r1; }
                        else { acc[ai][bj][m][1][2 * (e - 2)] *= r0; acc[ai][bj][m][1][2 * (e - 2) + 1] *= r1; }
                    }
                }
                __builtin_amdgcn_sched_barrier(0);
            }
    }
    DI void operator()(const Acc& acc, const Unit& u, int wr, int wc, int fr, int fq) const {
        const int row0 = u.pm * 256 + wr * 64 + fr;
#pragma unroll
        for (int ai = 0; ai < 2; ++ai)
#pragma unroll
            for (int m = 0; m < 4; ++m) {
                const int row = row0 + ai * 128 + m * 16;
#pragma unroll
                for (int bj = 0; bj < 2; ++bj) {
                    const int col = u.pn * 256 + bj * 128 + wc * 32 + fq * 8;
                    const u32x4 gv = *(const u32x4*)(g + (size_t)row * 6144 + 4096 + col); const f32x4 a0 = acc[ai][bj][m][0], a1 = acc[ai][bj][m][1];
                    u32x4 w; w.x = pk2(bflo(gv.x) * a0[0], bfhi(gv.x) * a0[1]); w.y = pk2(bflo(gv.y) * a0[2], bfhi(gv.y) * a0[3]);
                    w.z = pk2(bflo(gv.z) * a1[0], bfhi(gv.z) * a1[1]); w.w = pk2(bflo(gv.w) * a1[2], bfhi(gv.w) * a1[3]);
                    *(u32x4*)(o + (size_t)row * D + col) = w;
                }
            }
    }
};
struct EpiResid {
    static constexpr bool PERM = false, HOOK = false;
    const float *xinL, *xinC; float *xoutL, *xoutC; const float* mod; int goff; int pmoff;
    const float *stats, *lng, *lnb;
    DI void operator()(const Acc& acc, const Unit& u, int wr, int wc, int fr, int fq) const {
        const int pm = u.pm + pmoff; const bool latent = pm < 64;
        const float* xin = latent ? xinL : xinC - (size_t)ML * D; float* xout = latent ? xoutL : xoutC - (size_t)ML * D;
        const float* gate = mod + (size_t)(latent ? (pm >> 4) : 4) * 12288 + goff;
        const int row0 = pm * 256 + wr * 64 + fr;
#pragma unroll
        for (int bj = 0; bj < 2; ++bj)
#pragma unroll
            for (int n = 0; n < 2; ++n) {
                const int col = u.pn * 256 + bj * 128 + wc * 32 + n * 16 + fq * 4; const f32x4 gv = *(const f32x4*)(gate + col);
                f32x4 lg = (f32x4){1.f, 1.f, 1.f, 1.f}, lb = (f32x4){0.f, 0.f, 0.f, 0.f};
                if (stats) { lg = *(const f32x4*)(lng + col); lb = *(const f32x4*)(lnb + col); }
#pragma unroll
                for (int ai = 0; ai < 2; ++ai)
#pragma unroll
                    for (int m = 0; m < 4; ++m) {
                        const int row = row0 + ai * 128 + m * 16; const size_t off = (size_t)row * D + col;
                        f32x4 xv = *(const f32x4*)(xin + off);
                        if (stats) { const f32x2 st = *(const f32x2*)(stats + (size_t)row * 2); xv = (xv - st.x) * st.y * lg + lb; }
                        *(f32x4*)(xout + off) = xv * ALPHA + gv * acc[ai][bj][m][n];
                    }
            }
    }
};
DI float dpp_ror1(float v) { return __int_as_float(__builtin_amdgcn_mov_dpp(__float_as_int(v), 0x121, 0xf, 0xf, false)); }
DI float dpp_ror15(float v) { return __int_as_float(__builtin_amdgcn_mov_dpp(__float_as_int(v), 0x12f, 0xf, 0xf, false)); }
struct EpiFfnUp {
    static constexpr bool PERM = true, HOOK = false;
    bf16_t *hh, *sa, *sv; const float *fw, *fb;
    DI void operator()(const Acc& acc, const Unit& u, int wr, int wc, int fr, int fq) const {
        const int ch0 = u.pn * 128 + wc * 32 + fq * 8;
        const f32x4 w0a = *(const f32x4*)(fw + ch0), w0b = *(const f32x4*)(fw + ch0 + 4), w1a = *(const f32x4*)(fw + DFF + ch0), w1b = *(const f32x4*)(fw + DFF + ch0 + 4),
                    w2a = *(const f32x4*)(fw + 2 * DFF + ch0), w2b = *(const f32x4*)(fw + 2 * DFF + ch0 + 4), ba = *(const f32x4*)(fb + ch0), bb = *(const f32x4*)(fb + ch0 + 4);
#pragma unroll
        for (int ai = 0; ai < 2; ++ai)
#pragma unroll
            for (int m = 0; m < 4; ++m) {
                const int row = u.pm * 256 + ai * 128 + wr * 64 + m * 16 + fr;
                const f32x4 c0 = acc[ai][0][m][0], c1 = acc[ai][0][m][1], v0 = acc[ai][1][m][0], v1 = acc[ai][1][m][1];
                f32x4 p0, p1, n0, n1;
#pragma unroll
                for (int e = 0; e < 4; ++e) {
                    const float pc0 = dpp_ror1(c0[e]), pc1 = dpp_ror1(c1[e]), nc0 = dpp_ror15(c0[e]), nc1 = dpp_ror15(c1[e]);
                    const float pp0 = m > 0 ? dpp_ror1(acc[ai][0][m > 0 ? m - 1 : 0][0][e]) : pc0, pp1 = m > 0 ? dpp_ror1(acc[ai][0][m > 0 ? m - 1 : 0][1][e]) : pc1;
                    const float nn0 = m < 3 ? dpp_ror15(acc[ai][0][m < 3 ? m + 1 : 3][0][e]) : nc0, nn1 = m < 3 ? dpp_ror15(acc[ai][0][m < 3 ? m + 1 : 3][1][e]) : nc1;
                    p0[e] = fr == 0 ? pp0 : pc0; p1[e] = fr == 0 ? pp1 : pc1; n0[e] = fr == 15 ? nn0 : nc0; n1[e] = fr == 15 ? nn1 : nc1;
                }
                f32x4 x0 = p0 * w0a + c0 * w1a + n0 * w2a + ba, x1 = p1 * w0b + c1 * w1b + n1 * w2b + bb;
#pragma unroll
                for (int e = 0; e < 4; ++e) { x0[e] = x0[e] * sigm(x0[e]) * v0[e]; x1[e] = x1[e] * sigm(x1[e]) * v1[e]; }
                *(u32x4*)(hh + (size_t)row * DFF + ch0) = pack8(x0, x1);
                const int r64 = row & 63;
                if (r64 < 2 || r64 >= 62) {
                    *(u32x4*)(sa + (size_t)((row >> 6) * 4 + (r64 < 2 ? r64 : r64 - 60)) * DFF + ch0) = pack8(c0, c1);
                    if (r64 == 0 || r64 == 63) *(u32x4*)(sv + (size_t)((row >> 6) * 2 + (r64 ? 1 : 0)) * DFF + ch0) = pack8(v0, v1);
                }
            }
    }
};
struct EpiResidAtomic {
    static constexpr bool PERM = false, HOOK = false;
    float* xout; const float* gate;
    DI void operator()(const Acc& acc, const Unit& u, int wr, int wc, int fr, int fq) const {
        const int row0 = u.pm * 256 + wr * 64 + fr;
#pragma unroll
        for (int bj = 0; bj < 2; ++bj)
#pragma unroll
            for (int n = 0; n < 2; ++n) {
                const int col = u.pn * 256 + bj * 128 + wc * 32 + n * 16 + fq * 4; const f32x4 gv = *(const f32x4*)(gate + col);
#pragma unroll
                for (int ai = 0; ai < 2; ++ai)
#pragma unroll
                    for (int m = 0; m < 4; ++m) *(f32x4*)(xout + (size_t)(row0 + ai * 128 + m * 16) * D + col) = gv * acc[ai][bj][m][n];
            }
    }
};
struct EpiPlain {
    static constexpr bool PERM = true, HOOK = false;
    bf16_t* o; int ld;
    DI void operator()(const Acc& acc, const Unit& u, int wr, int wc, int fr, int fq) const {
        const int row0 = u.pm * 256 + wr * 64 + fr;
#pragma unroll
        for (int ai = 0; ai < 2; ++ai)
#pragma unroll
            for (int m = 0; m < 4; ++m)
#pragma unroll
                for (int bj = 0; bj < 2; ++bj)
                    *(u32x4*)(o + (size_t)(row0 + ai * 128 + m * 16) * ld + u.pn * 256 + bj * 128 + wc * 32 + fq * 8) = pack8(acc[ai][bj][m][0], acc[ai][bj][m][1]);
    }
};

DI int src_col(int kind, int n0, bool& perm) {
    perm = false;
    switch (kind) {
    case 1:
        if (n0 < 1536) { const int base = n0 < 768 ? 0 : 768; const int n1 = n0 < 768 ? n0 : n0 - 768; perm = true;
            return base + ((n1 >> 6) & 1) * 384 + (n1 >> 7) * 64 + ((n1 >> 5) & 1) * 32; }
        if (n0 < 2048) return 2304 + (n0 - 1536);
        if (n0 < 2304) return 2816 + (n0 - 2048);
        if (n0 < 8448) return 4672 + (n0 - 2304);
        if (n0 < 8512) { perm = true; return 3072 + (n0 - 8448); }
        return -1;
    case 2:
        return n0 < 768 ? 1536 + n0 : 3136 + (n0 - 768);
    case 3:
        if (n0 >= 1152) return -1;
        perm = (n0 % 192) >= 128; return n0;
    case 6: return ((n0 >> 7) & 1) * DFF + (n0 >> 8) * 128 + (n0 & 127);
    case 4: return (n0 >> 7) * 256 + (n0 & 127);
    case 5: return (n0 >> 7) * 256 + 128 + (n0 & 127);
    default: return n0;
    }
}
DI void tr_item(const float* W, int K, int Nsrc, bf16_t* WT, int ntile, int kind, const float* kscale, int item, LAS float* scr, int lane, int ldw) {
    const int kb = item / ntile, nb = item % ntile, k0 = 64 * kb, n0 = 32 * nb;
    bool perm; const int sc = src_col(kind, n0, perm);
    const int c = lane & 7;
    if (sc < 0) {
        unsigned zz = 0u; asm volatile("" : "+v"(zz));
#pragma unroll
        for (int j = 0; j < 4; ++j) { const int n = (lane >> 3) + 8 * j; *(u32x4*)(WT + (size_t)(n0 + n) * ldw + k0 + 8 * c) = (u32x4){zz, zz, zz, zz}; }
        return;
    }
#pragma unroll
    for (int i = 0; i < 32; ++i) { const int kk = 2 * i + (lane >> 5); float v = W[(size_t)(k0 + kk) * Nsrc + sc + (lane & 31)]; if (kscale) v *= kscale[k0 + kk]; scr[kk * 33 + (lane & 31)] = v; }
    LDS_WAIT();
#pragma unroll
    for (int j = 0; j < 4; ++j) { const int n = (lane >> 3) + 8 * j; const int ns = perm ? ((n & 1) * 16 + (n >> 1)) : n; const LAS float* s = scr + (8 * c) * 33 + ns;
        u32x4 o; o.x = pk2(s[0 * 33], s[1 * 33]); o.y = pk2(s[2 * 33], s[3 * 33]); o.z = pk2(s[4 * 33], s[5 * 33]); o.w = pk2(s[6 * 33], s[7 * 33]);
        *(u32x4*)(WT + (size_t)(n0 + n) * ldw + k0 + 8 * c) = o; }
    LDS_WAIT();
}
DI void convert_weights(const Args& a, int layer, LAS unsigned char* lds, int gw_in, int NGW, int wid_in, int lane_in) {
    int lane = lane_in, gw = gw_in, wid = wid_in; asm volatile("" : "+v"(lane), "+s"(gw), "+s"(wid));
    LAS float* scr = (LAS float*)(lds + wid * 8704);
    constexpr int C0 = 32 * 272, C1 = C0 + 32 * 72, C2 = C1 + 8 * 40, C3 = C2 + 4 * 24, C4 = C3 + 4 * 24, C5 = C4 + 12 * 64, C6 = C5 + 12 * 64, C7 = C6 + 8 * 64, C8 = C7 + 32 * 64,
                  C9 = C8 + 32 * 352, C10 = C9 + 88 * 64;
    for (int it = gw; it < C10; it += NGW) {
        const float* W; int K, Ns, nt, kind, item, ldw = 0; bf16_t* WT; const float* ksc = nullptr;
        if (it < C0) { W = ARG(I_WIN) + (size_t)layer * D * 10816; K = D; Ns = 10816; WT = (bf16_t*)(WSP() + O_WIN); nt = 272; kind = 1; item = it; }
        else if (it < C1) { W = ARG(I_WIN) + (size_t)layer * D * 10816; K = D; Ns = 10816; WT = (bf16_t*)(WSP() + O_WINT); nt = 72; kind = 2; item = it - C0; }
        else if (it < C2) { W = ARG(I_WUQ) + (size_t)layer * 512 * 1152; K = 512; Ns = 1152; WT = (bf16_t*)(WSP() + O_WUQ); nt = 40; kind = 3; item = it - C1; ksc = ARG(I_QG) + layer * 512; }
        else if (it < C3) { W = ARG(I_WUKV) + (size_t)layer * 256 * 1536; K = 256; Ns = 1536; WT = (bf16_t*)(WSP() + O_WUKV); nt = 24; kind = 4; item = it - C2; ksc = ARG(I_KVG) + layer * 256; }
        else if (it < C4) { W = ARG(I_WUKV) + (size_t)layer * 256 * 1536; K = 256; Ns = 1536; WT = (bf16_t*)(WSP() + O_WUKVT); nt = 24; kind = 5; item = it - C3; ksc = ARG(I_KVG) + layer * 256; }
        else if (it < C5) { W = ARG(I_WBA) + (size_t)layer * 768 * D; K = 768; Ns = D; WT = (bf16_t*)(WSP() + O_WBA); nt = 64; kind = 0; item = it - C4; ldw = 2048; }
        else if (it < C6) { W = ARG(I_WBB) + (size_t)layer * 768 * D; K = 768; Ns = D; WT = (bf16_t*)(WSP() + O_WBA) + 768; nt = 64; kind = 0; item = it - C5; ldw = 2048; }
        else if (it < C7) { W = ARG(I_WBC) + (size_t)layer * 512 * D; K = 512; Ns = D; WT = (bf16_t*)(WSP() + O_WBA) + 1536; nt = 64; kind = 0; item = it - C6; ldw = 2048; }
        else if (it < C8) { W = ARG(I_WOUT) + (size_t)layer * D * D; K = D; Ns = D; WT = (bf16_t*)(WSP() + O_WOUT); nt = 64; kind = 0; item = it - C7; }
        else if (it < C9) { W = ARG(I_WUP) + (size_t)layer * D * 11264; K = D; Ns = 11264; WT = (bf16_t*)(WSP() + O_WUP); nt = 352; kind = 6; item = it - C8; }
        else { W = ARG(I_WDN) + (size_t)layer * DFF * D; K = DFF; Ns = D; WT = (bf16_t*)(WSP() + O_WDN); nt = 64; kind = 0; item = it - C9; }
        tr_item(W, K, Ns, WT, nt, kind, ksc, item, scr, lane, ldw ? ldw : K);
    }
}

DI void ln_stats(const f32x4 (&v)[8], float& mean, float& rstd) {
    float s = 0.f;
#pragma unroll
    for (int j = 0; j < 8; ++j) s += (v[j][0] + v[j][1]) + (v[j][2] + v[j][3]);
    mean = wave_sum(s) * (1.f / D); float s2 = 0.f;
#pragma unroll
    for (int j = 0; j < 8; ++j) { const f32x4 d = v[j] - mean; s2 += (d[0] * d[0] + d[1] * d[1]) + (d[2] * d[2] + d[3] * d[3]); }
    rstd = 1.0f / sqrtf(wave_sum(s2) * (1.f / D) + EPS);
}
DI void ln_row(const float* xin, float* xo, const float* g, const float* bt, bf16_t* ao, const float* sh, const float* sc, int lane_in, const float* parts = nullptr, float* stats_out = nullptr) {
    int lane = lane_in; asm volatile("" : "+v"(lane));
    f32x4 v[8];
#pragma unroll
    for (int j = 0; j < 8; ++j) v[j] = *(const f32x4*)(xin + 256 * j + 4 * lane);
    if (parts) {
#pragma unroll
        for (int j = 0; j < 8; ++j) { const float* p = parts + 256 * j + 4 * lane;
            v[j] = v[j] * ALPHA + ((*(const f32x4*)p + *(const f32x4*)(p + (size_t)MC * D)) + (*(const f32x4*)(p + (size_t)2 * MC * D) + *(const f32x4*)(p + (size_t)3 * MC * D))); }
    }
    float mean, rstd;
    if (g) {
        ln_stats(v, mean, rstd);
        if (stats_out && lane == 0) *(f32x2*)stats_out = (f32x2){mean, rstd};
#pragma unroll
        for (int j = 0; j < 8; ++j) { const f32x4 gv = *(const f32x4*)(g + 256 * j + 4 * lane), bv = *(const f32x4*)(bt + 256 * j + 4 * lane); v[j] = (v[j] - mean) * rstd * gv + bv; }
        if (xo) {
#pragma unroll
            for (int j = 0; j < 8; ++j) *(f32x4*)(xo + 256 * j + 4 * lane) = v[j];
        }
    }
    if (ao) {
        ln_stats(v, mean, rstd);
#pragma unroll
        for (int j = 0; j < 8; ++j) { const f32x4 sv = *(const f32x4*)(sc + 256 * j + 4 * lane), hv = *(const f32x4*)(sh + 256 * j + 4 * lane);
            const f32x4 y = (v[j] - mean) * rstd * (sv + 1.0f) + hv; u32x2 w; w.x = pk2(y[0], y[1]); w.y = pk2(y[2], y[3]); *(u32x2*)(ao + 256 * j + 4 * lane) = w; }
    }
}

DI int crow(int r, int hi) { return (r & 3) + 8 * (r >> 2) + 4 * hi; }
#define MFMA32(a, b, c) __builtin_amdgcn_mfma_f32_32x32x16_bf16((a), (b), (c), 0, 0, 0)

template <int MODE>
DI void attn_unit(LAS unsigned char* lds, const bf16_t* Q, int ldq, const bf16_t* K1, const bf16_t* K2, const bf16_t* VT, bf16_t* O,
                  int b, int h, int qrow0, bool ctxstream, float lam, float outscale, const float* subg, int wid_s) {
    constexpr int KD = MODE ? 192 : 128, KS = KD * 2 + 16, KCH = KD / 8, KPT = 64 * KCH / 512;
    constexpr int KBYTES = 64 * KS, VS = 144, VBYTES = 128 * VS, BUF = KBYTES + VBYTES;
    constexpr int ND0 = MODE ? 12 : 4, NMAP = MODE ? 1 : 2;
    const int tid_ = tid_fresh(wid_s);
    const int tid = tid_, lane = tid & 63, wid = tid >> 6, r32 = lane & 31, hi = lane >> 5;
    const int nkt = ctxstream ? 4 : 68;
    LAS float* wsf = (LAS float*)(lds + 2 * BUF) + wid * 64;
    bf16x8 qf[MODE ? NMAP * ND0 : 1];
    LAS unsigned char* qlds = lds + 2 * BUF + 2048 + wid * (32 * 272);
    {
        const bf16_t* qp = Q + (size_t)(qrow0 + wid * 32 + r32) * ldq + h * KD + 8 * hi;
#pragma unroll
        for (int i = 0; i < NMAP * ND0; ++i) { const bf16x8 qv = *(const bf16x8*)(qp + 16 * i);
            if (MODE) qf[MODE ? i : 0] = qv; else *(LAS bf16x8*)(qlds + r32 * 272 + i * 32 + hi * 16) = qv; }
        LDS_WAIT();
    }
    const unsigned ko = (unsigned)((tid >> 4) * 768 + (tid & 15) * 8);
    const unsigned kd = (unsigned)((tid >> 4) * KS + (tid & 15) * 16);
    const unsigned ko2 = (unsigned)((tid >> 3) * 64 + (tid & 7) * 8), kd2 = (unsigned)((tid >> 3) * KS + 256 + (tid & 7) * 16);
    const unsigned vo = (unsigned)((tid >> 3) * NKEY + (tid & 7) * 8), vd = (unsigned)(KBYTES + (tid >> 3) * VS + (tid & 7) * 16);
    const bf16_t* vbase = VT + (size_t)(b * 768 + h * 128) * NKEY;
    u32x4 kreg[KPT], vreg[2];
#define ATT_LOAD(kt) do { const int krow_ = (kt) < 4 ? ML + b * 256 + (kt) * 64 : b * 4096 + ((kt) - 4) * 64; \
        const bf16_t* kb_ = K1 + (size_t)krow_ * 768 + h * 128; \
        kreg[0] = *(const u32x4*)(kb_ + ko); kreg[1] = *(const u32x4*)(kb_ + 32 * 768 + ko); \
        if (MODE) kreg[KPT - 1] = *(const u32x4*)(K2 + (size_t)krow_ * 64 + ko2); \
        const bf16_t* vb_ = vbase + (kt) * 64; \
        vreg[0] = *(const u32x4*)(vb_ + vo); vreg[1] = *(const u32x4*)(vb_ + (size_t)64 * NKEY + vo); } while (0)
#define ATT_STORE(bufp) do { *(LAS u32x4*)((bufp) + kd) = kreg[0]; *(LAS u32x4*)((bufp) + 32 * KS + kd) = kreg[1]; \
        if (MODE) *(LAS u32x4*)((bufp) + kd2) = kreg[KPT - 1]; \
        *(LAS u32x4*)((bufp) + vd) = vreg[0]; *(LAS u32x4*)((bufp) + 64 * VS + vd) = vreg[1]; } while (0)
    float mrun[NMAP], lrun[NMAP]; f32x16 oacc[NMAP][4];
#pragma unroll
    for (int s = 0; s < NMAP; ++s) { mrun[s] = -1e30f; lrun[s] = 0.f;
#pragma unroll
        for (int nb = 0; nb < 4; ++nb)
#pragma unroll
            for (int r = 0; r < 16; ++r) oacc[s][nb][r] = 0.f; }
    const int sig = (r32 & ~12) | ((r32 & 4) << 1) | ((r32 & 8) >> 1);
    const int kfrag = sig * KS + hi * 16, vfrag = KBYTES + r32 * VS + hi * 16;
    ATT_LOAD(0); ATT_STORE(lds); __syncthreads();
#pragma unroll
    for (int s = 0; s < NMAP; ++s) {
        float mx = -1e30f;
#pragma unroll
        for (int mf = 0; mf < 2; ++mf) {
            f32x16 p0;
#pragma unroll
            for (int r = 0; r < 16; ++r) p0[r] = 0.f;
#pragma unroll
            for (int d0 = 0; d0 < ND0; ++d0) {
                const bf16x8 a0 = *(const LAS bf16x8*)(lds + kfrag + mf * 32 * KS + (s * 4 + d0) * 32);
                const bf16x8 qv = MODE ? qf[MODE ? s * 4 + d0 : 0] : *(const LAS bf16x8*)(qlds + r32 * 272 + (s * 4 + d0) * 32 + hi * 16);
                p0 = MFMA32(a0, qv, p0);
            }
#pragma unroll
            for (int r = 0; r < 16; ++r) mx = fmaxf(mx, p0[r]);
        }
        mrun[s] = half_max(mx);
    }
    for (int kt = 0; kt < nkt; ++kt) {
        LAS unsigned char* buf = lds + (kt & 1) * BUF;
        if (kt + 1 < nkt) ATT_LOAD(kt + 1);
        constexpr int NBLK = ND0 / 4;
        bf16x8 kf[2][4], vfA[4], vfB[4];
#define ATT_LOADK(dst, s_, mf_, blk_) do { _Pragma("unroll") for (int d_ = 0; d_ < 4; ++d_) dst[d_] = *(const LAS bf16x8*)(buf + kfrag + (mf_) * 32 * KS + ((s_) * 4 + (blk_) * 4 + d_) * 32); } while (0)
        if constexpr (MODE == 0) {
#pragma unroll
            for (int mf = 0; mf < 2; ++mf) {
                f32x16 pp[2];
#pragma unroll
                for (int s = 0; s < 2; ++s) {
                    bf16x8 qb[4];
                    ATT_LOADK(kf[0], s, mf, 0);
#pragma unroll
                    for (int d = 0; d < 4; ++d) qb[d] = *(const LAS bf16x8*)(qlds + r32 * 272 + (s * 4 + d) * 32 + hi * 16);
#pragma unroll
                    for (int r = 0; r < 16; ++r) pp[s][r] = 0.f;
                    __builtin_amdgcn_sched_barrier(0);
#pragma unroll
                    for (int d = 0; d < 4; ++d) pp[s] = MFMA32(kf[0][d], qb[d], pp[s]);
                }
#pragma unroll
                for (int nb = 0; nb < 4; ++nb) vfA[nb] = *(const LAS bf16x8*)(buf + vfrag + nb * 32 * VS + (2 * mf) * 32);
                __builtin_amdgcn_sched_barrier(0);
                u32x4 pw[2][2];
#pragma unroll
                for (int s = 0; s < 2; ++s) {
                    float mx = pp[s][0];
#pragma unroll
                    for (int r = 1; r < 16; ++r) mx = fmaxf(mx, pp[s][r]);
                    if (__any(mx > mrun[s] + 64.0f)) {
                        mx = half_max(mx);
                        const float mn = fmaxf(mrun[s], mx); const float alpha = __builtin_amdgcn_exp2f(mrun[s] - mn); mrun[s] = mn; lrun[s] *= alpha;
                        if (hi == 0) wsf[r32] = alpha;
                        LDS_WAIT();
#pragma unroll
                        for (int r = 0; r < 16; ++r) { const float f = wsf[crow(r, hi)];
#pragma unroll
                            for (int nb = 0; nb < 4; ++nb) oacc[s][nb][r] *= f; }
                        LDS_WAIT();
                    }
                    const float mr = mrun[s]; float rs = 0.f;
#pragma unroll
                    for (int r = 0; r < 16; ++r) { pp[s][r] = __builtin_amdgcn_exp2f(pp[s][r] - mr); rs += pp[s][r]; }
                    lrun[s] += rs;
#pragma unroll
                    for (int j = 0; j < 2; ++j)
                        pw[s][j] = (u32x4){pk2(pp[s][8 * j], pp[s][8 * j + 1]), pk2(pp[s][8 * j + 2], pp[s][8 * j + 3]), pk2(pp[s][8 * j + 4], pp[s][8 * j + 5]), pk2(pp[s][8 * j + 6], pp[s][8 * j + 7])};
                }
#pragma unroll
                for (int nb = 0; nb < 4; ++nb) vfB[nb] = *(const LAS bf16x8*)(buf + vfrag + nb * 32 * VS + (2 * mf + 1) * 32);
                __builtin_amdgcn_sched_barrier(0);
#pragma unroll
                for (int nb = 0; nb < 4; ++nb) { oacc[0][nb] = MFMA32(__builtin_bit_cast(bf16x8, pw[0][0]), vfA[nb], oacc[0][nb]); oacc[NMAP - 1][nb] = MFMA32(__builtin_bit_cast(bf16x8, pw[1][0]), vfA[nb], oacc[NMAP - 1][nb]); }
                __builtin_amdgcn_sched_barrier(0);
#pragma unroll
                for (int nb = 0; nb < 4; ++nb) { oacc[0][nb] = MFMA32(__builtin_bit_cast(bf16x8, pw[0][1]), vfB[nb], oacc[0][nb]); oacc[NMAP - 1][nb] = MFMA32(__builtin_bit_cast(bf16x8, pw[1][1]), vfB[nb], oacc[NMAP - 1][nb]); }
            }
        } else {
            f32x16 pp[2];
#pragma unroll
            for (int mf = 0; mf < 2; ++mf)
#pragma unroll
                for (int r = 0; r < 16; ++r) pp[mf][r] = 0.f;
            ATT_LOADK(kf[0], 0, 0, 0);
#pragma unroll
            for (int q = 0; q < 6; ++q) {
                if (q + 1 < 6) ATT_LOADK(kf[(q + 1) & 1], 0, (q + 1) / 3, (q + 1) % 3);
                __builtin_amdgcn_sched_barrier(0);
#pragma unroll
                for (int d = 0; d < 4; ++d) pp[q / 3] = MFMA32(kf[q & 1][d], qf[MODE ? (q % 3) * 4 + d : 0], pp[q / 3]);
            }
#pragma unroll
            for (int nb = 0; nb < 4; ++nb) vfA[nb] = *(const LAS bf16x8*)(buf + vfrag + nb * 32 * VS);
            __builtin_amdgcn_sched_barrier(0);
            float mx = fmaxf(pp[0][0], pp[1][0]);
#pragma unroll
            for (int r = 1; r < 16; ++r) mx = fmaxf(mx, fmaxf(pp[0][r], pp[1][r]));
            if (__any(mx > mrun[0] + 64.0f)) {
                mx = half_max(mx);
                const float mn = fmaxf(mrun[0], mx); const float alpha = __builtin_amdgcn_exp2f(mrun[0] - mn); mrun[0] = mn; lrun[0] *= alpha;
                if (hi == 0) wsf[r32] = alpha;
                LDS_WAIT();
#pragma unroll
                for (int r = 0; r < 16; ++r) { const float f = wsf[crow(r, hi)];
#pragma unroll
                    for (int nb = 0; nb < 4; ++nb) oacc[0][nb][r] *= f; }
                LDS_WAIT();
            }
            u32x4 pw[4];
            {
                const float mr = mrun[0]; float rs = 0.f;
#pragma unroll
                for (int mf = 0; mf < 2; ++mf) {
#pragma unroll
                    for (int r = 0; r < 16; ++r) { pp[mf][r] = __builtin_amdgcn_exp2f(pp[mf][r] - mr); rs += pp[mf][r]; }
#pragma unroll
                    for (int j = 0; j < 2; ++j)
                        pw[2 * mf + j] = (u32x4){pk2(pp[mf][8 * j], pp[mf][8 * j + 1]), pk2(pp[mf][8 * j + 2], pp[mf][8 * j + 3]), pk2(pp[mf][8 * j + 4], pp[mf][8 * j + 5]), pk2(pp[mf][8 * j + 6], pp[mf][8 * j + 7])};
                }
                lrun[0] += rs;
            }
#pragma unroll
            for (int vb = 0; vb < 4; ++vb) {
                if (vb + 1 < 4) {
                    if (vb & 1) {
#pragma unroll
                        for (int nb = 0; nb < 4; ++nb) vfA[nb] = *(const LAS bf16x8*)(buf + vfrag + nb * 32 * VS + (vb + 1) * 32);
                    } else {
#pragma unroll
                        for (int nb = 0; nb < 4; ++nb) vfB[nb] = *(const LAS bf16x8*)(buf + vfrag + nb * 32 * VS + (vb + 1) * 32);
                    }
                }
                __builtin_amdgcn_sched_barrier(0);
#pragma unroll
                for (int nb = 0; nb < 4; ++nb) oacc[0][nb] = MFMA32(__builtin_bit_cast(bf16x8, pw[vb]), (vb & 1) ? vfB[nb] : vfA[nb], oacc[0][nb]);
            }
        }
#undef ATT_LOADK
        if (kt + 1 < nkt) ATT_STORE(lds + ((kt + 1) & 1) * BUF);
        __syncthreads();
    }
#undef ATT_LOAD
#undef ATT_STORE
    const int orow = qrow0 + wid * 32;
    if (MODE == 0) {
        const float l1 = half_sum(lrun[0]), l2 = half_sum(lrun[NMAP - 1]);
        if (hi == 0) { wsf[r32] = 1.0f / l1; wsf[32 + r32] = lam / l2; }
        LDS_WAIT();
        float ss[16];
#pragma unroll
        for (int r = 0; r < 16; ++r) { const float i1 = wsf[crow(r, hi)], i2 = wsf[32 + crow(r, hi)]; float s = 0.f;
#pragma unroll
            for (int nb = 0; nb < 4; ++nb) { const float o = oacc[0][nb][r] * i1 - oacc[NMAP - 1][nb][r] * i2; oacc[0][nb][r] = o; s += o * o; }
            ss[r] = s; }
#pragma unroll
        for (int r = 0; r < 16; ++r) {
            ss[r] = sum32(ss[r]);
            ss[r] = outscale / sqrtf(ss[r] * (1.f / 128.f) + EPS);
        }
#pragma unroll
        for (int nb = 0; nb < 4; ++nb) { const float gg = subg[nb * 32 + r32];
#pragma unroll
            for (int r = 0; r < 16; ++r) O[(size_t)(orow + crow(r, hi)) * 2048 + h * 128 + nb * 32 + r32] = f2bf(oacc[0][nb][r] * ss[r] * gg); }
        LDS_WAIT();
    } else {
        const float l1 = half_sum(lrun[0]);
        if (hi == 0) wsf[r32] = 1.0f / l1;
        LDS_WAIT();
#pragma unroll
        for (int r = 0; r < 16; ++r) { const float i1 = wsf[crow(r, hi)];
#pragma unroll
            for (int nb = 0; nb < 4; ++nb) O[(size_t)(orow + crow(r, hi)) * 2048 + h * 128 + nb * 32 + r32] = f2bf(oacc[0][nb][r] * i1); }
        LDS_WAIT();
    }
    __syncthreads();
}

DI float conv3(const bf16_t* u, int t, int n, float w0, float w1, float w2, float bias) {
    float acc = bf2f(u[t]) * w1 + bias;
    if (t > 0) acc += bf2f(u[t - 1]) * w0;
    if (t < n - 1) acc += bf2f(u[t + 1]) * w2;
    return acc;
}
DI int zaddr(int bb, int t) { return bb * 8576 + (t >> 8) * 528 + (t & 255) * 2; }
DI void hyena_unit(LAS unsigned char* lds, const Args& a, int layer, bool isctx, int c, int bp, const bf16_t* Rf, const bf16_t* uT, bf16_t* Oc, int wid_s) {
    const int n = isctx ? 256 : 4096, NT1 = n >> 8;
    LAS unsigned char* cp = lds; LAS unsigned char* Z = lds + 131072;
    const int tid_ = tid_fresh(wid_s);
    const int tid = tid_, lane = tid & 63, wid = tid >> 6, r32 = lane & 31, hi = lane >> 5, t1 = r32 >> 1, bb = r32 & 1, b = 2 * bp + bb;
    const float* cw = ARG(I_HCW) + (size_t)layer * 3 * 1536; const float* cb = ARG(I_HCB) + (size_t)layer * 1536;
    {
        const float w0 = cw[c], w1 = cw[1536 + c], w2 = cw[3072 + c], bs = cb[c];
#pragma unroll 4
        for (int e = tid; e < 2 * n; e += 512) { const int b_ = e / n, t = e % n;
            *(LAS bf16_t*)(Z + zaddr(b_, t)) = f2bf(conv3(uT + ((size_t)((2 * bp + b_) * 1536 + c)) * n, t, n, w0, w1, w2, bs)); }
    }
#pragma unroll 1
    for (int order = 0; order < 2; ++order) {
        const bf16_t* R = Rf + (size_t)(order * 512 + c) * (2 * n);
        for (int g = tid_fresh(wid_s); g < 1024; g += 512) { const int X8 = g * 8; const int B = n - 4096 + X8;
            u32x4 lo = (u32x4){0u, 0u, 0u, 0u}, hh = lo;
            if (B >= 0 && B < 2 * n) lo = *(const u32x4*)(R + B);
            if (B + 8 >= 0 && B + 8 < 2 * n) hh = *(const u32x4*)(R + B + 8);
            const unsigned w[8] = {lo.x, lo.y, lo.z, lo.w, hh.x, hh.y, hh.z, hh.w};
#pragma unroll
            for (int cc = 0; cc < 8; ++cc) { const int sft = 7 - cc; u32x4 o;
                if ((sft & 1) == 0) o = (u32x4){w[sft / 2], w[sft / 2 + 1], w[sft / 2 + 2], w[sft / 2 + 3]};
                else o = (u32x4){__builtin_amdgcn_alignbit(w[sft / 2 + 1], w[sft / 2], 16), __builtin_amdgcn_alignbit(w[sft / 2 + 2], w[sft / 2 + 1], 16),
                                 __builtin_amdgcn_alignbit(w[sft / 2 + 3], w[sft / 2 + 2], 16), __builtin_amdgcn_alignbit(w[sft / 2 + 4], w[sft / 2 + 3], 16)};
                *(LAS u32x4*)(cp + cc * 16384 + X8 * 2) = o; }
        }
        __syncthreads();
        f32x16 acc[8];
#pragma unroll
        for (int cc = 0; cc < 8; ++cc)
#pragma unroll
            for (int r = 0; r < 16; ++r) acc[cc][r] = 0.f;
        {
            const int d0 = -15 + 4 * wid, d1 = (wid == 7) ? 16 : d0 + 4;
#pragma unroll 1
            for (int d = d0; d < d1; ++d) {
                const int s1 = t1 - d; const bool valid = (s1 >= 0) && (s1 < 16);
                const LAS unsigned char* ab = cp + (4088 - 256 * d - 8 * r32 + 8 * hi) * 2;
                const LAS unsigned char* zb = Z + bb * 8576 + (valid ? s1 : 0) * 528 + hi * 16;
                bf16x8 Bc = *(const LAS bf16x8*)(zb), Bn = Bc, Aa[4], Ab[4];
#pragma unroll
                for (int c4 = 0; c4 < 4; ++c4) Aa[c4] = *(const LAS bf16x8*)(ab + c4 * 16384);
                if (!valid) Bc = (bf16x8){0, 0, 0, 0, 0, 0, 0, 0};
#pragma unroll 1
                for (int kk = 0; kk < 16; ++kk) {
#pragma unroll
                    for (int c4 = 0; c4 < 4; ++c4) Ab[c4] = *(const LAS bf16x8*)(ab + (4 + c4) * 16384 + kk * 32);
                    __builtin_amdgcn_sched_barrier(0);
#pragma unroll
                    for (int c4 = 0; c4 < 4; ++c4) acc[c4] = MFMA32(Aa[c4], Bc, acc[c4]);
                    const int kn = kk < 15 ? kk + 1 : 15;
                    Bn = *(const LAS bf16x8*)(zb + kn * 32);
#pragma unroll
                    for (int c4 = 0; c4 < 4; ++c4) Aa[c4] = *(const LAS bf16x8*)(ab + c4 * 16384 + kn * 32);
                    __builtin_amdgcn_sched_barrier(0);
#pragma unroll
                    for (int c4 = 0; c4 < 4; ++c4) acc[4 + c4] = MFMA32(Ab[c4], Bc, acc[4 + c4]);
                    if (!valid) Bn = (bf16x8){0, 0, 0, 0, 0, 0, 0, 0};
                    Bc = Bn;
                }
            }
        }
        __syncthreads();
        f32x16 yv;
#pragma unroll
        for (int half = 0; half < 2; ++half) {
            LAS float* xs = (LAS float*)cp;
#pragma unroll
            for (int c = 0; c < 4; ++c)
#pragma unroll
                for (int r = 0; r < 16; ++r) xs[((c * 8 + wid) * 16 + r) * 64 + lane] = acc[half * 4 + c][r];
            __syncthreads();
            if ((wid >> 2) == half) {
                const int c = wid & 3;
#pragma unroll
                for (int r = 0; r < 16; ++r) { float sm = 0.f;
#pragma unroll
                    for (int v = 0; v < 8; ++v) sm += xs[((c * 8 + v) * 16 + r) * 64 + lane];
                    yv[r] = sm; __builtin_amdgcn_sched_barrier(0); }
            }
            __syncthreads();
        }
        __syncthreads();
        {
            const int g_tid = tid_fresh(wid_s), g_lane = g_tid & 63, wid = g_tid >> 6, r32 = g_lane & 31, hi = g_lane >> 5, t1 = r32 >> 1, bb = r32 & 1, b = 2 * bp + bb;
            const int part = order ? 1024 : 512;
            const float w0 = cw[part + c], w1 = cw[1536 + part + c], w2 = cw[3072 + part + c], bs = cb[part + c];
            const float skip = ARG(I_HSKIP)[(size_t)layer * 1024 + order * 512 + c];
            const bf16_t* ug = uT + ((size_t)(b * 1536 + part + c)) * n;
            int wv = wid; asm volatile("" : "+v"(wv));
#pragma unroll
            for (int r = 0; r < 16; ++r) {
                const int t = 256 * t1 + 8 * crow(r, hi) + wv;
                const float zold = bf2f(*(const LAS bf16_t*)(Z + zaddr(bb, t)));
                const float gate = conv3(ug, t, n, w0, w1, w2, bs);
                const float zn = gate * (yv[r] + skip * zold);
                if (order == 0) *(LAS bf16_t*)(Z + zaddr(bb, t)) = f2bf(zn);
                else Oc[(size_t)(isctx ? ML + b * 256 + t : b * 4096 + t) * 2048 + c] = f2bf(zn);
            }
        }
        __syncthreads();
    }
}

DI void hyena_ctx_unit(LAS unsigned char* lds, int layer, int c, int bp, const bf16_t* Rf, const bf16_t* uT, bf16_t* Oc, int wid_s) {
    const int tid = tid_fresh(wid_s), b_ = tid >> 8, t = tid & 255, b = 2 * bp + b_;
    LAS float* zf = (LAS float*)lds; LAS float* rf = (LAS float*)(lds + 2048);
    const float* cw = ARG(I_HCW) + (size_t)layer * 3 * 1536; const float* cb = ARG(I_HCB) + (size_t)layer * 1536;
    float z = conv3(uT + (size_t)(b * 1536 + c) * 256, t, 256, cw[c], cw[1536 + c], cw[3072 + c], cb[c]);
#pragma unroll 1
    for (int order = 0; order < 2; ++order) {
        zf[b_ * 256 + t] = z; rf[tid] = bf2f(Rf[(size_t)(order * 512 + c) * 512 + tid]);
        __syncthreads();
        float y = 0.f; const LAS float* rp = rf + (255 - t); const LAS float* zp = zf + b_ * 256;
#pragma unroll 8
        for (int s2 = 0; s2 < 256; ++s2) y += rp[s2] * zp[s2];
        const int part = order ? 1024 : 512;
        const float gate = conv3(uT + (size_t)(b * 1536 + part + c) * 256, t, 256, cw[part + c], cw[1536 + part + c], cw[3072 + part + c], cb[part + c]);
        z = gate * (y + ARG(I_HSKIP)[(size_t)layer * 1024 + order * 512 + c] * z);
        __syncthreads();
    }
    Oc[(size_t)(ML + b * 256 + t) * 2048 + c] = f2bf(z);
}

#define XB_TMO      128
#define XB_XCNT(j)  (256  + 64 * (j))
#define XB_XSUB(j)  (1280 + 64 * (j))
#define XB_XGEN(j)  (2304 + 64 * (j))
#define XB_TOP      3328
#define XB_TOPGEN   3392
#define XB_SPIN_CAP (1u << 18)
DI unsigned xb_ld(unsigned* p) { return __hip_atomic_load(p, __ATOMIC_RELAXED, __HIP_MEMORY_SCOPE_AGENT); }
DI unsigned xb_add(unsigned* p, unsigned v) { return __hip_atomic_fetch_add(p, v, __ATOMIC_RELAXED, __HIP_MEMORY_SCOPE_AGENT); }
DI unsigned xb_xcc_id() { return (unsigned)__builtin_amdgcn_s_getreg((3 << 11) | 20) & 0xFu; }
#define XB_SPIN(cond, bar) do { unsigned _sp = 0; while (cond) { __builtin_amdgcn_s_sleep(1); \
    if ((++_sp & 255u) == 0u) { if (xb_ld(&(bar)[XB_TMO])) break; if (_sp > XB_SPIN_CAP) { atomicAdd(&(bar)[XB_TMO], 1u); break; } } } } while (0)
DI void xcd_barrier_complete(unsigned* bar, unsigned x, unsigned& nloc, unsigned& nx) {
    const unsigned G = gridDim.x * gridDim.y * gridDim.z;
    unsigned sum, cnt, mine, sp = 0u;
    for (;;) {
        sum = 0u; cnt = 0u; mine = 0u;
#pragma unroll
        for (unsigned j = 0; j < 16; ++j) { const unsigned c = xb_ld(&bar[XB_XCNT(j)]); sum += c; cnt += (c > 0u) ? 1u : 0u; mine = (j == x) ? c : mine; }
        if (sum == G) break;
        __builtin_amdgcn_s_sleep(1);
        if ((++sp & 255u) == 0u) { if (xb_ld(&bar[XB_TMO])) break; if (sp > XB_SPIN_CAP) { atomicAdd(&bar[XB_TMO], 1u); break; } }
    }
    nloc = mine > 0u ? mine : 1u; nx = cnt > 0u ? cnt : 1u;
}
DI void xcd_barrier(unsigned* bar, volatile LAS unsigned* st) {
    asm volatile("s_waitcnt vmcnt(0)" ::: "memory");
    __syncthreads();
    if (threadIdx.x == 0) {
        const unsigned x = xb_xcc_id();
        __builtin_amdgcn_s_waitcnt(0);
        unsigned nloc = st[0], nx = st[1];
        if (nloc == 0u) { xcd_barrier_complete(bar, x, nloc, nx); st[0] = nloc; st[1] = nx; }
        const unsigned old = xb_add(&bar[XB_XSUB(x)], 1u);
        const unsigned gen = old / nloc;
        if (old + 1u == (gen + 1u) * nloc) {
            __builtin_amdgcn_fence(__ATOMIC_RELEASE, "agent");
            asm volatile("s_waitcnt vmcnt(0)" ::: "memory");
            const unsigned og = xb_add(&bar[XB_TOP], 1u);
            const unsigned tg = og / nx;
            if (og + 1u == (tg + 1u) * nx) xb_add(&bar[XB_TOPGEN], 1u);
            else XB_SPIN(xb_ld(&bar[XB_TOPGEN]) == tg, bar);
            __builtin_amdgcn_fence(__ATOMIC_ACQUIRE, "agent");
            xb_add(&bar[XB_XGEN(x)], 1u);
            asm volatile("s_waitcnt vmcnt(0)" ::: "memory");
        } else {
            XB_SPIN(xb_ld(&bar[XB_XGEN(x)]) == gen, bar);
            __builtin_amdgcn_fence(__ATOMIC_ACQUIRE, "agent");
            asm volatile("s_waitcnt vmcnt(0)" ::: "memory");
        }
    }
    __syncthreads();
}
#define GBAR() xcd_barrier((unsigned*)(WSP() + O_BAR), (volatile LAS unsigned*)(lds + LDS_BYTES - 16))

__global__ void __launch_bounds__(512) fwd_kernel(Args a) {
    extern __shared__ __attribute__((aligned(16))) unsigned char smem[];
    LAS unsigned char* lds = (LAS unsigned char*)smem;
    const int wid = wave_id(), G = gridDim.x, bid = blockIdx.x;
    const int gw = bid * 8 + wid, NGW = G * 8;
    { unsigned* barw = (unsigned*)(WSP() + O_BAR) + XB_XCNT(xb_xcc_id());
      if (threadIdx.x == 0) { volatile LAS unsigned* st = (volatile LAS unsigned*)(lds + LDS_BYTES - 16); st[0] = 0u; st[1] = 0u;
        (void)xb_add(barw, 1u); } }
    __syncthreads();
    float* modb = (float*)(WSP() + O_MOD); float* lamb = (float*)(WSP() + O_LAM); f32x2* ropeb = (f32x2*)(WSP() + O_ROPE); float* hsum = (float*)(WSP() + O_HSUM);
    float* pq = (float*)(WSP() + O_PQ); float* pkv = (float*)(WSP() + O_PKV);
    float* xc = (float*)(WSP() + O_XC);
    bf16_t* Abuf = (bf16_t*)(WSP() + O_A);

    {
        const int tid = tid_fresh(wid), lane = tid & 63;
        LAS float* sc = (LAS float*)lds;
        if (bid < 384) {
            for (int e = tid; e < 5 * 2048; e += 512) { const int r = e >> 11, k = e & 2047; const float v = r < 4 ? ARG(I_C)[r * 2048 + k] : ARG(I_CCTX)[k]; sc[e] = v / (1.f + __expf(-v)); }
            __syncthreads();
            LAS float* red = (LAS float*)(lds + 40960);
            for (int it = bid; it < 384; it += G) {
                const int layer = it / 192, cgp = it % 192, j = tid & 63, kg = tid >> 6, col = cgp * 64 + j;
                const float* W = ARG(I_ADAW) + (size_t)layer * D * 12288 + col;
                float ac[5] = {0.f, 0.f, 0.f, 0.f, 0.f};
#pragma unroll 16
                for (int k = kg * 256; k < kg * 256 + 256; ++k) { const float w = W[(size_t)k * 12288];
#pragma unroll
                    for (int r = 0; r < 5; ++r) ac[r] += sc[r * 2048 + k] * w; }
#pragma unroll
                for (int r = 0; r < 5; ++r) red[(kg * 5 + r) * 64 + j] = ac[r];
                __syncthreads();
                if (tid < 320) { const int r = tid >> 6; float s = 0.f;
#pragma unroll
                    for (int q = 0; q < 8; ++q) s += red[(q * 5 + r) * 64 + j];
                    modb[(size_t)(layer * 5 + r) * 12288 + col] = s + ARG(I_ADAB)[layer * 12288 + col]; }
                __syncthreads();
            }
        }
        __syncthreads();
        {
            LAS float* feat = (LAS float*)lds;
            LAS float* hA = (LAS float*)(lds + 2048);
            LAS float* hB = (LAS float*)(lds + 4096);
            for (int it = bid; it < 1056; it += G) {
                const int set = it < 512 ? 0 : (it < 1024 ? 1 : 2); const int layer = set == 1 ? 1 : 0; const int n = set == 2 ? 256 : 4096;
                const int t0 = (set == 0 ? it : (set == 1 ? it - 512 : it - 1024)) * 8;
                float* H = (float*)(WSP() + O_HTMP) + (size_t)(set == 0 ? 0 : (set == 1 ? 4096 : 8192)) * 2048;
                const float* w1 = ARG(I_HW1) + layer * 33 * 64; const float* b1 = ARG(I_HB1) + layer * 64;
                const float* w2 = ARG(I_HW2) + layer * 4096;   const float* b2 = ARG(I_HB2) + layer * 64;
                const float* w3 = ARG(I_HW3) + layer * 4096;   const float* b3 = ARG(I_HB3) + layer * 64;
                const float* w4 = ARG(I_HW4) + (size_t)layer * 64 * 2048; const float* fr_ = ARG(I_HFREQ) + layer * 64;
                if (tid < 8 * 33) { const int tt = tid / 33, k = tid % 33; const int t = t0 + tt; float v;
                    if (k == 0) v = (float)t / (float)(n - 1);
                    else { const int bnd = (k - 1) & 15; const float band = 1e-4f + (float)bnd * ((15.0f - 1e-4f) / 15.0f); const float ph = ((float)(6.283185307179586 / n) * (float)t) * band;
                        v = k <= 16 ? cosf(ph) : -sinf(ph); }
                    feat[tt * 40 + k] = v; }
                __syncthreads();
                const int tt = tid >> 6, j = tid & 63; const float fq_ = fr_[j];
                { float s = b1[j]; for (int k = 0; k < 33; ++k) s += feat[tt * 40 + k] * w1[k * 64 + j]; hA[tt * 64 + j] = sinf(fq_ * s); }
                __syncthreads();
                { float s = b2[j]; for (int k = 0; k < 64; ++k) s += hA[tt * 64 + k] * w2[k * 64 + j]; hB[tt * 64 + j] = sinf(fq_ * s); }
                __syncthreads();
                { float s = b3[j]; for (int k = 0; k < 64; ++k) s += hB[tt * 64 + k] * w3[k * 64 + j]; hA[tt * 64 + j] = sinf(fq_ * s); }
                __syncthreads();
#pragma unroll 1
                for (int q = 0; q < 4; ++q) {
                    const int jj = tid + 512 * q; float o[8] = {0.f, 0.f, 0.f, 0.f, 0.f, 0.f, 0.f, 0.f};
#pragma unroll 1
                    for (int k0 = 0; k0 < 64; k0 += 16) {
                        float w[16];
#pragma unroll
                        for (int kk = 0; kk < 16; ++kk) w[kk] = w4[(k0 + kk) * 2048 + jj];
#pragma unroll
                        for (int kk = 0; kk < 16; ++kk)
#pragma unroll
                            for (int x = 0; x < 8; ++x) o[x] += hA[x * 64 + k0 + kk] * w[kk];
                    }
                    const int ch = jj & 511, dir = (jj >> 9) & 1;
                    const float delta = fabsf(-3.0701134573253946f + (float)ch * ((-15.350567286626973f + 3.0701134573253946f) / 511.0f));
                    float asum = 0.f;
#pragma unroll
                    for (int x = 0; x < 8; ++x) { const int t = t0 + x; const float tl = (float)t / (float)(n - 1); const float v = o[x] * expf(-tl * delta);
                        H[(size_t)t * 2048 + jj] = v; if (dir == 0 || t <= n - 2) asum += fabsf(v); }
                    atomicAdd(hsum + set * 2048 + jj, asum);
                }
                __syncthreads();
            }
        }
        if (bid == G - 1) {
            if (tid < 2) {
                const float* dl = ARG(I_LAMBDA) + tid * 256; float s1 = 0.f, s2 = 0.f;
                for (int k = 0; k < 64; ++k) { s1 += dl[k] * dl[64 + k]; s2 += dl[128 + k] * dl[192 + k]; }
                const float li = 0.8f - 0.6f * expf(-0.3f * (float)tid);
                lamb[tid * 2] = expf(s1) - expf(s2) + li; lamb[tid * 2 + 1] = li;
            }
            for (int e = tid; e < 1024; e += 512) { const int pos = e >> 4, jj = e & 15; const float inv = powf(10000.0f, -(float)jj / 16.0f); const float ang = (float)pos * inv;
                ropeb[e] = (f32x2){cosf(ang), sinf(ang)}; }
        }
        __syncthreads();
        convert_weights(a, 0, lds, gw, NGW, wid, lane);
    }
    cg::this_grid().sync();
    {
        const int tid = tid_fresh(wid), lane = tid & 63;
        for (int it = bid; it < 2 * 1024 + 2 * 1024 + 2 * 64; it += G) {
            int set, r = it; if (r < 2048) set = 0; else if (r < 4096) { set = 1; r -= 2048; } else { set = 2; r -= 4096; }
            const int n = set == 2 ? 256 : 4096; const int ng = 2 * n / 8; const int o = r / ng, xg = r % ng;
            const float* H = (const float*)(WSP() + O_HTMP) + (size_t)(set == 0 ? 0 : (set == 1 ? 4096 : 8192)) * 2048;
            bf16_t* Rb = (bf16_t*)(WSP() + (set == 0 ? O_FILT0 : (set == 1 ? O_FILT1 : O_FILTC)));
            const int c = tid; const float nrm = 1.0f / (hsum[set * 2048 + o * 1024 + c] + hsum[set * 2048 + o * 1024 + 512 + c]);
            float v[8];
#pragma unroll
            for (int i = 0; i < 8; ++i) { const int x = xg * 8 + i; const int dl = (n - 1) - x;
                v[i] = dl >= 0 ? H[(size_t)dl * 2048 + o * 1024 + c] * nrm : (dl > -n ? H[(size_t)(-dl - 1) * 2048 + o * 1024 + 512 + c] * nrm : 0.f); }
            *(u32x4*)(Rb + (size_t)(o * 512 + c) * (2 * n) + xg * 8) = (u32x4){pk2(v[0], v[1]), pk2(v[2], v[3]), pk2(v[4], v[5]), pk2(v[6], v[7])};
        }
        for (int row = gw; row < MT; row += NGW) {
            const float* xin = row < ML ? ARG(I_X) + (size_t)row * D : ARG(I_CTX) + (size_t)(row - ML) * D;
            const float* md = modb + (size_t)(row < ML ? (row >> 12) : 4) * 12288;
            ln_row(xin, nullptr, nullptr, nullptr, Abuf + (size_t)row * D, md, md + 2048, lane);
        }
    }
    GBAR();

#pragma unroll 1
    for (int layer = 0; layer < 2; ++layer) {
        const float* modl = modb + (size_t)layer * 5 * 12288;
        const int MU = layer == 0 ? MT : ML;
        {
            const int nq = layer == 0 ? 1 : 4;
#pragma unroll 1
            for (int q = 0; q < nq; ++q) {
                int M_ = MT, N_ = NWIN, pmo = 0, pno = 0, cix = bid; size_t aoff = 0, boff = 0;
                if (layer != 0) {
                    if (q == 0) { M_ = ML; }
                    else { M_ = MC; pmo = 64; aoff = (size_t)ML * D; pno = q == 1 ? 3 : (q == 2 ? 8 : 33); N_ = q == 1 ? 768 : 256; boff = (size_t)pno * 256 * D; cix = (bid - (q == 1 ? 192 : (q == 2 ? 204 : 208)) + G) % G; }
                }
                EpiWin E{(bf16_t*)(WSP() + O_QDA), (bf16_t*)(WSP() + O_KDA), (bf16_t*)(WSP() + O_QLAT), (bf16_t*)(WSP() + O_KVLAT), (bf16_t*)(WSP() + O_G), (bf16_t*)(WSP() + O_KR), pq, pkv, ropeb, pmo, pno};
                pg8::Gemm g{Abuf + aoff, (const bf16_t*)(WSP() + O_WIN) + boff, M_, N_, D};
                pg8::gemm_phase<EpiWin, false>(lds, g, G, cix, E, wid);
            }
            const int nt_ = layer == 0 ? 1 : 2;
#pragma unroll 1
            for (int q = 0; q < nt_; ++q) {
                int M_ = MT, N_ = NWINT, pmo = 0, cix = (bid + G - 8) % G; size_t aoff = 0;
                if (layer != 0) {
                    if (q == 0) { M_ = ML; cix = (bid + G - 128) % G; }
                    else { M_ = MC; N_ = 768; pmo = 64; aoff = (size_t)ML * D; cix = (bid - 212 + G) % G; }
                }
                EpiWinT ET{(bf16_t*)(WSP() + O_VDAT), (bf16_t*)(WSP() + O_HYT), (bf16_t*)(WSP() + O_HYTC), pmo};
                pg8::Gemm gt{Abuf + aoff, (const bf16_t*)(WSP() + O_WINT), M_, N_, D};
                pg8::gemm_phase<EpiWinT, true>(lds, gt, G, cix, ET, wid);
            }
        }
        GBAR();
        {
            EpiUq E1{(bf16_t*)(WSP() + O_QM), pq, ropeb};
            pg8::Gemm g1{(const bf16_t*)(WSP() + O_QLAT), (const bf16_t*)(WSP() + O_WUQ), MU, NUQ, 512};
            pg8::gemm_phase<EpiUq, false>(lds, g1, G, bid, E1, wid);
            EpiUkv E2{(bf16_t*)(WSP() + O_KN), pkv};
            pg8::Gemm g2{(const bf16_t*)(WSP() + O_KVLAT), (const bf16_t*)(WSP() + O_WUKV), MT, 768, 256};
            pg8::gemm_phase<EpiUkv, false>(lds, g2, G, (bid + 88) % G, E2, wid);
            EpiUkvT E3{(bf16_t*)(WSP() + O_VBT), pkv};
            pg8::Gemm g3{(const bf16_t*)(WSP() + O_KVLAT), (const bf16_t*)(WSP() + O_WUKVT), MT, 768, 256};
            pg8::gemm_phase<EpiUkvT, true>(lds, g3, G, (bid + 40) % G, E3, wid);
        }
        GBAR();
        {
            if (wid >= 4) __builtin_amdgcn_s_setprio(1);
            const float lam = __uint_as_float(__builtin_amdgcn_readfirstlane(__float_as_uint(lamb[layer * 2]))), lam_init = __uint_as_float(__builtin_amdgcn_readfirstlane(__float_as_uint(lamb[layer * 2 + 1])));
            const int nctx = layer == 0 ? 24 : 0; const int NA = 768 + 2 * nctx;
            int bid_l = (G % 8 == 0) ? (bid % 8) * (G / 8) + bid / 8 : bid;
            asm volatile("" : "+s"(bid_l));
            for (int u = bid_l; u < NA; u += G) {
                int mode, idx; bool cs;
                if (u < 384) { mode = 0; idx = u; cs = false; } else if (u < 768) { mode = 1; idx = u - 384; cs = false; } else if (u < 768 + nctx) { mode = 0; idx = u - 768; cs = true; } else { mode = 1; idx = u - 768 - nctx; cs = true; }
                int b, h, qrow0;
                if (!cs) { const int bh = idx >> 4, qb = idx & 15; b = bh / 6; h = bh % 6; qrow0 = b * 4096 + qb * 256; } else { b = idx / 6; h = idx % 6; qrow0 = ML + b * 256; }
                if (mode == 0) attn_unit<0>(lds, (const bf16_t*)(WSP() + O_QDA), 768, (const bf16_t*)(WSP() + O_KDA), nullptr, (const bf16_t*)(WSP() + O_VDAT), (bf16_t*)(WSP() + O_OA), b, h, qrow0, cs, lam, 1.0f - lam_init, ARG(I_SUBG) + layer * 128, wid);
                else attn_unit<1>(lds, (const bf16_t*)(WSP() + O_QM), 1152, (const bf16_t*)(WSP() + O_KN), (const bf16_t*)(WSP() + O_KR), (const bf16_t*)(WSP() + O_VBT), (bf16_t*)(WSP() + O_OA) + 768, b, h, qrow0, cs, 0.f, 1.f, nullptr, wid);
            }
            const int NH = layer == 0 ? 2048 : 1024;
            for (int u = bid_l; u < NH; u += G) {
                const bool cs = u >= 1024; const int idx = cs ? u - 1024 : u; const int c = idx >> 1, bp = idx & 1;
                if (cs) hyena_ctx_unit(lds, layer, c, bp, (const bf16_t*)(WSP() + O_FILTC), (const bf16_t*)(WSP() + O_HYTC), (bf16_t*)(WSP() + O_OA) + 1536, wid);
                else hyena_unit(lds, a, layer, false, c, bp, (const bf16_t*)(WSP() + (layer == 0 ? O_FILT0 : O_FILT1)), (const bf16_t*)(WSP() + O_HYT), (bf16_t*)(WSP() + O_OA) + 1536, wid);
            }
        }
        __builtin_amdgcn_s_setprio(0);
        GBAR();
        {
            EpiMerge E{(const bf16_t*)(WSP() + O_G), Abuf};
            pg8::Gemm g{(const bf16_t*)(WSP() + O_OA), (const bf16_t*)(WSP() + O_WBA), MU, D, D};
            pg8::gemm_phase<EpiMerge, false>(lds, g, G, bid, E, wid);
        }
        GBAR();
        {
            EpiResid E{layer == 0 ? ARG(I_X) : AOUT(), layer == 0 ? ARG(I_CTX) : xc, AOUT(), xc, modl, 2 * 2048, 0,
                       layer == 0 ? nullptr : (const float*)(WSP() + O_ST2), ARG(I_LN2G), ARG(I_LN2B)};
            pg8::Gemm g{Abuf, (const bf16_t*)(WSP() + O_WOUT), ML, D, D};
            pg8::gemm_phase<EpiResid, false>(lds, g, G, bid, E, wid);
            if (layer == 0) {
#pragma unroll 1
                for (int ks = 0; ks < 4; ++ks) {
                    EpiResidAtomic Ea{(float*)(WSP() + O_QM) + (size_t)ks * MC * D, modl + (size_t)4 * 12288 + 2 * 2048};
                    pg8::Gemm gs{Abuf + (size_t)ML * D + ks * 512, (const bf16_t*)(WSP() + O_WOUT) + ks * 512, MC, D, 512, D};
                    pg8::gemm_phase<EpiResidAtomic, false>(lds, gs, G, (bid - 32 * ks + G) % G, Ea, wid);
                }
            }
        }
        GBAR();
        for (int row = gw; row < MU; row += NGW) {
            float* xr = row < ML ? AOUT() + (size_t)row * D : xc + (size_t)(row - ML) * D;
            const float* md = modl + (size_t)(row < ML ? (row >> 12) : 4) * 12288;
            const bool cx = row >= ML;
            ln_row(cx ? ARG(I_CTX) + (size_t)(row - ML) * D : xr, cx ? xr : nullptr, ARG(I_LN1G) + layer * D, ARG(I_LN1B) + layer * D, Abuf + (size_t)row * D, md + 3 * 2048, md + 4 * 2048, lane_id(),
                   cx ? (const float*)(WSP() + O_QM) + (size_t)(row - ML) * D : nullptr, cx ? nullptr : (float*)(WSP() + O_ST1) + (size_t)row * 2);
        }
        GBAR();
        {
            bf16_t* HH = (bf16_t*)(WSP() + O_HH);
            const float* fw = ARG(I_FCW) + (size_t)layer * 3 * DFF; const float* fb = ARG(I_FCB) + (size_t)layer * DFF;
            {
                EpiFfnUp E{HH, (bf16_t*)(WSP() + O_SA), (bf16_t*)(WSP() + O_SV), fw, fb};
                pg8::Gemm g{Abuf, (const bf16_t*)(WSP() + O_WUP), MU, 11264, D};
                pg8::gemm_phase<EpiFfnUp, false>(lds, g, G, bid, E, wid);
            }
            GBAR();
            {
                const bf16_t* SA = (const bf16_t*)(WSP() + O_SA); const bf16_t* SV = (const bf16_t*)(WSP() + O_SV);
                int tl = tid_fresh(wid), bid_l = bid; asm volatile("" : "+s"(bid_l));
                for (int e = bid_l * 512 + tl; e < (MU / 32) * 704; e += G * 512) {
                    const int ri = e / 704, c8 = (e % 704) * 8; const int blk = ri >> 1, last = ri & 1; const int row = blk * 64 + (last ? 63 : 0);
                    const int seqlen = row < ML ? 4096 : 256; const int pos = (row < ML ? row : row - ML) & (seqlen - 1);
                    const bf16_t* pa; const bf16_t* ca; const bf16_t* na; float m0 = 1.f, m2 = 1.f;
                    if (!last) { ca = SA + (size_t)(blk * 4 + 0) * DFF; na = SA + (size_t)(blk * 4 + 1) * DFF; pa = pos > 0 ? SA + (size_t)((blk - 1) * 4 + 3) * DFF : ca; m0 = pos > 0 ? 1.f : 0.f; }
                    else { pa = SA + (size_t)(blk * 4 + 2) * DFF; ca = SA + (size_t)(blk * 4 + 3) * DFF; na = pos < seqlen - 1 ? SA + (size_t)((blk + 1) * 4 + 0) * DFF : ca; m2 = pos < seqlen - 1 ? 1.f : 0.f; }
                    const u32x4 a0 = *(const u32x4*)(pa + c8), a1 = *(const u32x4*)(ca + c8), a2 = *(const u32x4*)(na + c8), vv = *(const u32x4*)(SV + (size_t)ri * DFF + c8);
                    float o[8];
#pragma unroll
                    for (int i = 0; i < 4; ++i) {
                        const unsigned w0 = a0[i], w1 = a1[i], w2 = a2[i], wv = vv[i]; const int ch = c8 + 2 * i;
                        float x = bflo(w0) * (m0 * fw[ch]) + bflo(w1) * fw[DFF + ch] + bflo(w2) * (m2 * fw[2 * DFF + ch]) + fb[ch];
                        o[2 * i] = x * sigm(x) * bflo(wv);
                        x = bfhi(w0) * (m0 * fw[ch + 1]) + bfhi(w1) * fw[DFF + ch + 1] + bfhi(w2) * (m2 * fw[2 * DFF + ch + 1]) + fb[ch + 1];
                        o[2 * i + 1] = x * sigm(x) * bfhi(wv);
                    }
                    *(u32x4*)(HH + (size_t)row * DFF + c8) = (u32x4){pk2(o[0], o[1]), pk2(o[2], o[3]), pk2(o[4], o[5]), pk2(o[6], o[7])};
                }
            }
            GBAR();
            {
                EpiResid E{AOUT(), xc, AOUT(), xc, modl, 5 * 2048, 0, (const float*)(WSP() + O_ST1), ARG(I_LN1G) + layer * D, ARG(I_LN1B) + layer * D};
                pg8::Gemm g{HH, (const bf16_t*)(WSP() + O_WDN), ML, D, DFF};
                pg8::gemm_phase<EpiResid, false>(lds, g, G, bid, E, wid);
                if (layer == 0) {
#pragma unroll 1
                    for (int ks = 0; ks < 4; ++ks) {
                        EpiResidAtomic Ea{(float*)(WSP() + O_QM) + (size_t)ks * MC * D, modl + (size_t)4 * 12288 + 5 * 2048};
                        pg8::Gemm gs{HH + (size_t)ML * DFF + ks * 1408, (const bf16_t*)(WSP() + O_WDN) + ks * 1408, MC, D, 1408, DFF};
                        pg8::gemm_phase<EpiResidAtomic, false>(lds, gs, G, (bid - 32 * ks + G) % G, Ea, wid);
                    }
                }
            }
            GBAR();
        }
        {
            const float* modn = modb + (size_t)5 * 12288;
            for (int row = gw; row < MU; row += NGW) {
                float* xr = row < ML ? AOUT() + (size_t)row * D : xc + (size_t)(row - ML) * D;
                const float* md = modn + (size_t)(row < ML ? (row >> 12) : 4) * 12288;
                const bool keep = (layer == 0 && row < ML);
                ln_row(xr, keep ? nullptr : xr, ARG(I_LN2G) + layer * D, ARG(I_LN2B) + layer * D, layer == 0 ? Abuf + (size_t)row * D : nullptr, md, md + 2048, lane_id(),
                       row >= ML ? (const float*)(WSP() + O_QM) + (size_t)(row - ML) * D : nullptr, keep ? (float*)(WSP() + O_ST2) + (size_t)row * 2 : nullptr);
            }
            if (layer == 0) { __syncthreads(); convert_weights(a, 1, lds, gw, NGW, wid, lane_id()); GBAR(); }
        }
    }
}

extern "C" void kernel_launch(void* const* d_in, const int* in_sizes, int n_in, void* d_out, int out_size, void* d_ws, size_t ws_size, hipStream_t stream) {
    static int grid = 0;
    if (grid == 0) {
        if (n_in != 36 || ws_size < WS_END) { fprintf(stderr, "kernel_launch: n_in %d ws %zu (need %zu)\n", n_in, ws_size, (size_t)WS_END); grid = -1; return; }
        int dev = 0, cus = 0, per_cu = 0;
        hipGetDevice(&dev);
        hipDeviceGetAttribute(&cus, hipDeviceAttributeMultiprocessorCount, dev);
        hipFuncSetAttribute((const void*)fwd_kernel, hipFuncAttributeMaxDynamicSharedMemorySize, LDS_BYTES);
        hipOccupancyMaxActiveBlocksPerMultiprocessor(&per_cu, (const void*)fwd_kernel, 512, LDS_BYTES);
        if (per_cu < 1) per_cu = 1;
        grid = cus * 1;
        (void)hipGetLastError();
    }
    if (grid < 0) return;
    hipMemsetAsync(d_ws, 0, ZERO_BYTES, stream);
    Args a{};
    for (int i = 0; i < 36; ++i) a.in[i] = (const float*)d_in[i];
    a.out = (float*)d_out; a.ws = (unsigned char*)d_ws;
    void* args[] = {&a};
    hipError_t e = hipLaunchCooperativeKernel((const void*)fwd_kernel, dim3(grid), dim3(512), args, LDS_BYTES, stream);
    if (e != hipSuccess) fprintf(stderr, "cooperative launch failed: %s (grid %d)\n", hipGetErrorString(e), grid);
}
```

```cpp
#include <hip/hip_runtime.h>
#include <hip/hip_cooperative_groups.h>
#include <cstdio>
#include <cstdint>
namespace cg = cooperative_groups;

#define LAS __attribute__((address_space(3)))
#define DI __device__ __forceinline__
typedef unsigned short bf16_t;
typedef short bf16x8 __attribute__((ext_vector_type(8)));
typedef float f32x2 __attribute__((ext_vector_type(2)));
typedef float f32x4 __attribute__((ext_vector_type(4)));
typedef float f32x16 __attribute__((ext_vector_type(16)));
typedef unsigned u32x2 __attribute__((ext_vector_type(2)));
typedef unsigned u32x4 __attribute__((ext_vector_type(4)));
typedef __bf16 bf16x2_t __attribute__((ext_vector_type(2)));

DI unsigned pk2(float lo, float hi) { f32x2 v = {lo, hi}; bf16x2_t b = __builtin_convertvector(v, bf16x2_t); return __builtin_bit_cast(unsigned, b); }
DI bf16_t f2bf(float f) { return (bf16_t)(pk2(f, 0.f) & 0xffffu); }
DI float bf2f(bf16_t h) { return __uint_as_float(((unsigned)h) << 16); }
DI float bflo(unsigned w) { return __uint_as_float(w << 16); }
DI float bfhi(unsigned w) { return __uint_as_float(w & 0xffff0000u); }
template <int M> DI float swz(float v) { return __int_as_float(__builtin_amdgcn_ds_swizzle(__float_as_int(v), (M << 10) | 0x1f)); }
DI float half_sum(float v) { auto rr = __builtin_amdgcn_permlane32_swap(__float_as_uint(v), __float_as_uint(v), false, false); return __uint_as_float(rr[0]) + __uint_as_float(rr[1]); }
DI float half_max(float v) { auto rr = __builtin_amdgcn_permlane32_swap(__float_as_uint(v), __float_as_uint(v), false, false); return fmaxf(__uint_as_float(rr[0]), __uint_as_float(rr[1])); }
DI float sum32(float v) { v += swz<1>(v); v += swz<2>(v); v += swz<4>(v); v += swz<8>(v); v += swz<16>(v); return v; }
DI float wave_sum(float v) { return half_sum(sum32(v)); }
#define LDS_WAIT() asm volatile("s_waitcnt lgkmcnt(0)" ::: "memory")
DI int lane_id() { int l; asm volatile("v_mbcnt_lo_u32_b32 %0, -1, 0\n\tv_mbcnt_hi_u32_b32 %0, -1, %0" : "=v"(l)); return l; }
DI int wave_id() { return __builtin_amdgcn_readfirstlane((int)threadIdx.x >> 6); }
DI int tid_fresh(int wid_s) { int t = wid_s * 64 + lane_id(); asm volatile("" : "+v"(t)); return t; }

constexpr int D = 2048, NBATCH = 4, SEQ = 4096, CTXL = 256, ML = 16384, MC = 1024, MT = 17408, NKEY = 4352, DFF = 5632;
constexpr int NWIN = 8704, NWINT = 2304, NUQ = 1280;
constexpr float EPS = 1e-6f;
constexpr float ALPHA = 1.41421356237f;
constexpr float LOG2E = 1.4426950408889634f;
constexpr float QS_DA = 0.125f * LOG2E;
constexpr float QS_MLA = 0.07216878364870322f * LOG2E;

constexpr size_t al(size_t x) { return (x + 255) & ~(size_t)255; }
constexpr size_t O_MOD = 0;
constexpr size_t O_LAM = al(O_MOD + (size_t)2 * 5 * 12288 * 4);
constexpr size_t O_ROPE = O_LAM + 256;
constexpr size_t O_HSUM = al(O_ROPE + 64 * 16 * 8);
constexpr size_t O_BAR = al(O_HSUM + 3 * 2048 * 4);
constexpr size_t O_PQ = al(O_BAR + 16384);
constexpr size_t O_PKV = al(O_PQ + (size_t)MT * 8 * 4);
constexpr size_t O_ST1 = al(O_PKV + (size_t)MT * 4 * 4);
constexpr size_t O_ST2 = O_ST1 + (size_t)ML * 8;
constexpr size_t O_FILT0 = al(O_ST2 + (size_t)ML * 8);
constexpr size_t FILT_SZ = (size_t)2 * 512 * 8192 * 2;
constexpr size_t O_FILT1 = O_FILT0 + FILT_SZ;
constexpr size_t O_FILTC = O_FILT1 + FILT_SZ;
constexpr size_t O_XC = al(O_FILTC + (size_t)2 * 512 * 512 * 2);
constexpr size_t O_WIN = al(O_XC + (size_t)MC * D * 4);
constexpr size_t O_WINT = O_WIN + (size_t)NWIN * D * 2;
constexpr size_t O_WUQ = O_WINT + (size_t)NWINT * D * 2;
constexpr size_t O_WUKV = O_WUQ + (size_t)NUQ * 512 * 2;
constexpr size_t O_WUKVT = O_WUKV + (size_t)768 * 256 * 2;
constexpr size_t O_WBA = O_WUKVT + (size_t)768 * 256 * 2;
constexpr size_t O_WBB = O_WBA + (size_t)2048 * 768 * 2;
constexpr size_t O_WBC = O_WBB + (size_t)2048 * 768 * 2;
constexpr size_t O_WOUT = O_WBC + (size_t)2048 * 512 * 2;
constexpr size_t O_WUP = O_WOUT + (size_t)2048 * 2048 * 2;
constexpr size_t O_WDN = O_WUP + (size_t)11264 * 2048 * 2;
constexpr size_t O_R = al(O_WDN + (size_t)2048 * 5632 * 2);
constexpr size_t O_QDA = O_R;
constexpr size_t O_KDA = O_QDA + (size_t)MT * 768 * 2;
constexpr size_t O_VDAT = O_KDA + (size_t)MT * 768 * 2;
constexpr size_t O_QLAT = O_VDAT + (size_t)4 * 768 * NKEY * 2;
constexpr size_t O_KVLAT = O_QLAT + (size_t)MT * 512 * 2;
constexpr size_t O_HYT = O_KVLAT + (size_t)MT * 256 * 2;
constexpr size_t O_HYTC = O_HYT + (size_t)4 * 1536 * 4096 * 2;
constexpr size_t O_G = O_HYTC + (size_t)4 * 1536 * 256 * 2;
constexpr size_t O_KR = O_G + (size_t)MT * 6144 * 2;
constexpr size_t O_REND = O_KR + (size_t)MT * 64 * 2;
constexpr size_t O_HTMP = O_R;
constexpr size_t O_HH = O_R;
constexpr size_t O_SA = O_HH + (size_t)MT * DFF * 2;
constexpr size_t O_SV = O_SA + (size_t)(MT / 16) * DFF * 2;
static_assert(O_SV + (size_t)(MT / 32) * DFF * 2 <= O_REND, "FFN overlay");
static_assert(O_HTMP + (size_t)(2 * 4096 + 256) * 2048 * 4 <= O_REND, "H overlay");
constexpr size_t O_A = al(O_REND);
constexpr size_t O_QM = O_A + (size_t)MT * 2048 * 2;
constexpr size_t O_KN = O_QM + (size_t)MT * 1152 * 2;
constexpr size_t O_VBT = O_KN + (size_t)MT * 768 * 2;
constexpr size_t O_OA = O_VBT + (size_t)4 * 768 * NKEY * 2;
constexpr size_t O_OB = O_OA + (size_t)MT * 768 * 2;
constexpr size_t O_OC = O_OB + (size_t)MT * 768 * 2;
constexpr size_t WS_END = O_OC + (size_t)MT * 512 * 2;
constexpr size_t ZERO_BYTES = O_PQ;

constexpr int LDS_BYTES = 155648;

struct Args { const float* in[36]; float* out; unsigned char* ws; };
enum { I_X = 0, I_C, I_CTX, I_CCTX, I_ADAW, I_ADAB, I_WIN, I_LAMBDA, I_SUBG, I_QG, I_WUQ, I_KVG, I_WUKV, I_HCW, I_HCB, I_HW1, I_HB1, I_HW2, I_HB2,
       I_HW3, I_HB3, I_HW4, I_HFREQ, I_HSKIP, I_WBA, I_WBB, I_WBC, I_WOUT, I_LN1G, I_LN1B, I_WUP, I_FCW, I_FCB, I_WDN, I_LN2G, I_LN2B };

typedef const float* cfp_t;
DI cfp_t ARG(int i) { const __attribute__((address_space(4))) cfp_t* p = (const __attribute__((address_space(4))) cfp_t*)__builtin_amdgcn_kernarg_segment_ptr(); asm volatile("" : "+s"(p)); return p[i]; }
#define AOUT() ((float*)ARG(36))
#define WSP() ((unsigned char*)ARG(37))

namespace pg8 {
constexpr int BM = 256, BK = 64, HALF = 128, HTB = HALF * BK * 2, NXCD = 8, WGM = 8;
__host__ __device__ __forceinline__ int lds_byte(int r, int c) { const int st = (r >> 4) * 2 + (c >> 5), rr = r & 15, cc = c & 31, ob = rr * 64 + cc * 2; return st * 1024 + (ob ^ (((ob >> 9) & 1) << 5)); }
__host__ __device__ __forceinline__ void stage_rc(int b, int& R, int& C) { const int st = b / 1024, sb = b % 1024, swz = sb ^ (((sb >> 9) & 1) << 5); R = (st >> 1) * 16 + swz / 64; C = (st & 1) * 32 + (swz % 64) / 2; }
__host__ __device__ __forceinline__ int perm32(int rho) { const int n = rho >> 4, i = rho & 15; return 8 * (i >> 2) + 4 * n + (i & 3); }
struct Unit { int pm, pn; };
struct Gemm { const bf16_t* A; const bf16_t* Bt; int M, N, K; int ld = 0; };
struct StaticOrder {
    int nM, nN, nwg, G, c;
    __device__ void init(int M, int N, int G_, int c_) { nM = M / BM; nN = N / BM; nwg = nM * nN; G = G_; c = c_; }
    __device__ bool next(int i, Unit& u) const {
        const long L = (long)i * G + c; if (L >= nwg) return false;
        int wgid = (int)L; { const int q = nwg / NXCD, r = nwg % NXCD, xcd = wgid % NXCD, off = wgid / NXCD; wgid = (xcd < r ? xcd * (q + 1) : r * (q + 1) + (xcd - r) * q) + off; }
        const int nig = WGM * nN, gid = wgid / nig, fm = gid * WGM, gsz = (nM - fm) < WGM ? (nM - fm) : WGM;
        u.pm = fm + ((wgid % nig) % gsz); u.pn = (wgid % nig) / gsz; return true;
    }
};
template <class Epi, bool TRANSOUT>
__device__ __forceinline__ void gemm_phase(LAS unsigned char* lds, const Gemm g, int G, int cidx, const Epi& E, int wid_s) {
    const int tid_ = tid_fresh(wid_s);
    const int tid = tid_, wid = __builtin_amdgcn_readfirstlane(tid >> 6), lane = tid & 63, wr = wid >> 2, wc = wid & 3, fr = lane & 15, fq = lane >> 4;
    const int K = g.K, nt = K / BK, LD = g.ld ? g.ld : g.K;
    int G_ = G, cidx_ = cidx; asm volatile("" : "+s"(G_), "+s"(cidx_));
    StaticOrder S; S.init(g.M, g.N, G_, cidx_);
    unsigned voffA[2], voffB[2];
#pragma unroll
    for (int i = 0; i < 2; ++i) { int R, C; stage_rc(tid * 16 + i * 8192, R, C); const int Rb = Epi::PERM ? ((R & ~31) + perm32(R & 31)) : R;
        voffA[i] = (unsigned)(R * LD + C) * 2u; voffB[i] = (unsigned)(Rb * LD + C) * 2u; }
    const size_t kstep = (size_t)(BK * 2);
    const size_t hstep = (size_t)HALF * LD * 2;
    const size_t tstep = 2 * hstep;
    const unsigned ldsw = (unsigned)wid * 1024u;
    const int aoff = lds_byte(wr * 64 + fr, fq * 8), boff = lds_byte(wc * 32 + fr, fq * 8);
#define PG8_SA(b, h) (((b) * 2 + (h)) * HTB)
#define PG8_SB(b, h) ((4 + (b) * 2 + (h)) * HTB)
#define PG8_STAGE(bufoff, gbase, voff) do { _Pragma("unroll") for (int _i = 0; _i < 2; ++_i) \
        __builtin_amdgcn_global_load_lds((const unsigned*)((const char*)(gbase) + (voff)[_i]), (LAS unsigned*)(lds + (bufoff) + ldsw + _i * 8192), 16, 0, 0); } while (0)
#define PG8_LDA(dst, b, h) do { _Pragma("unroll") for (int m = 0; m < 4; ++m) _Pragma("unroll") for (int k = 0; k < 2; ++k) dst[m][k] = *(const LAS bf16x8*)(lds + PG8_SA(b, h) + aoff + m * 2048 + k * 1024); } while (0)
#define PG8_LDB(dst, b, h) do { _Pragma("unroll") for (int n = 0; n < 2; ++n) _Pragma("unroll") for (int k = 0; k < 2; ++k) dst[n][k] = *(const LAS bf16x8*)(lds + PG8_SB(b, h) + boff + n * 2048 + k * 1024); } while (0)
#define PG8_MMA(ai, bj, At, Bt) do { __builtin_amdgcn_s_setprio(1); _Pragma("unroll") for (int m = 0; m < 4; ++m) _Pragma("unroll") for (int n = 0; n < 2; ++n) _Pragma("unroll") for (int k = 0; k < 2; ++k) \
        acc[ai][bj][m][n] = TRANSOUT ? __builtin_amdgcn_mfma_f32_16x16x32_bf16(At[m][k], Bt[n][k], acc[ai][bj][m][n], 0, 0, 0) \
                                     : __builtin_amdgcn_mfma_f32_16x16x32_bf16(Bt[n][k], At[m][k], acc[ai][bj][m][n], 0, 0, 0); __builtin_amdgcn_s_setprio(0); } while (0)
#define PG8_WAIT_V(n) asm volatile("s_waitcnt vmcnt(" #n ")" ::: "memory")
#define PG8_WAIT_L(n) asm volatile("s_waitcnt lgkmcnt(" #n ")" ::: "memory")
#define PG8_BAR __builtin_amdgcn_s_barrier()
#define PG8_SCHED __builtin_amdgcn_sched_barrier(0)
    Unit cur, nxt; int ui = 0;
    if (!S.next(0, cur)) return;
    f32x4 acc[2][2][4][2];
#pragma unroll
    for (int a = 0; a < 2; ++a)
#pragma unroll
        for (int b = 0; b < 2; ++b)
#pragma unroll
            for (int m = 0; m < 4; ++m)
#pragma unroll
                for (int n = 0; n < 2; ++n) acc[a][b][m][n] = (f32x4){0.f, 0.f, 0.f, 0.f};
    bf16x8 At[4][2], B0[2][2], B1[2][2];
    const char* cA = (const char*)g.A + (size_t)cur.pm * tstep; const char* cB = (const char*)g.Bt + (size_t)cur.pn * tstep;
    PG8_STAGE(PG8_SB(0, 0), cB, voffB); PG8_STAGE(PG8_SB(0, 1), cB + hstep, voffB); PG8_STAGE(PG8_SA(0, 0), cA, voffA); PG8_STAGE(PG8_SA(0, 1), cA + hstep, voffA);
    if (wr == 1) PG8_BAR;
    PG8_WAIT_V(2); PG8_BAR;
    PG8_STAGE(PG8_SB(1, 0), cB + kstep, voffB); PG8_STAGE(PG8_SA(1, 0), cA + kstep, voffA); PG8_STAGE(PG8_SB(1, 1), cB + hstep + kstep, voffB);
    PG8_WAIT_V(6); PG8_BAR;
    for (;;) {
        const bool has_next = S.next(ui + 1, nxt);
        const char* nA = has_next ? (const char*)g.A + (size_t)nxt.pm * tstep : cA; const char* nB = has_next ? (const char*)g.Bt + (size_t)nxt.pn * tstep : cB;
        for (int t = 0; t < nt; t += 2) {
            if constexpr (Epi::HOOK) { if (t == 12 || t == 24) { int fr_ = fr, fq_ = fq; asm volatile("" : "+v"(fr_), "+v"(fq_)); E.hook(acc, cur, t, wr, wc, fr_, fq_); } }
            const bool last = (t == nt - 2);
            const char* a1 = cA + (size_t)(t + 1) * kstep;
            const char* a2 = last ? nA : cA + (size_t)(t + 2) * kstep; const char* b2 = last ? nB : cB + (size_t)(t + 2) * kstep;
            const char* a3 = a2 + kstep; const char* b3 = b2 + kstep;
            PG8_LDB(B0, 0, 0); PG8_LDB(B1, 0, 1); PG8_SCHED; PG8_LDA(At, 0, 0); PG8_STAGE(PG8_SA(1, 1), a1 + hstep, voffA);
            PG8_WAIT_V(8); PG8_WAIT_L(0); PG8_BAR; PG8_MMA(0, 0, At, B0); PG8_MMA(0, 1, At, B1); PG8_BAR; PG8_SCHED;
            PG8_LDA(At, 0, 1); PG8_STAGE(PG8_SB(0, 0), b2, voffB); PG8_STAGE(PG8_SB(0, 1), b2 + hstep, voffB); PG8_STAGE(PG8_SA(0, 0), a2, voffA);
            PG8_WAIT_V(8); PG8_WAIT_L(0); PG8_BAR; PG8_MMA(1, 0, At, B0); PG8_MMA(1, 1, At, B1); PG8_BAR; PG8_SCHED;
            PG8_LDB(B0, 1, 0); PG8_LDB(B1, 1, 1); PG8_SCHED; PG8_LDA(At, 1, 0); PG8_STAGE(PG8_SA(0, 1), a2 + hstep, voffA);
            PG8_WAIT_V(8); PG8_WAIT_L(0); PG8_BAR; PG8_MMA(0, 0, At, B0); PG8_MMA(0, 1, At, B1); PG8_BAR; PG8_SCHED;
            PG8_LDA(At, 1, 1); PG8_STAGE(PG8_SB(1, 0), b3, voffB); PG8_STAGE(PG8_SB(1, 1), b3 + hstep, voffB); PG8_STAGE(PG8_SA(1, 0), a3, voffA);
            PG8_WAIT_V(8); PG8_WAIT_L(0); PG8_BAR; PG8_MMA(1, 0, At, B0); PG8_MMA(1, 1, At, B1); PG8_BAR; PG8_SCHED;
        }
        if (wr == 0) PG8_BAR;
        { int fr_ = fr, fq_ = fq, wr_ = wr, wc_ = wc; asm volatile("" : "+v"(fr_), "+v"(fq_), "+s"(wr_), "+s"(wc_));
          E(acc, cur, wr_, wc_, fr_, fq_); }
        if (!has_next) break;
#pragma unroll
        for (int a = 0; a < 2; ++a)
#pragma unroll
            for (int b = 0; b < 2; ++b)
#pragma unroll
                for (int m = 0; m < 4; ++m)
#pragma unroll
                    for (int n = 0; n < 2; ++n) acc[a][b][m][n] = (f32x4){0.f, 0.f, 0.f, 0.f};
        cur = nxt; cA = nA; cB = nB; ++ui;
        if (wr == 1) PG8_BAR;
    }
    PG8_WAIT_V(0);
    PG8_BAR;
#undef PG8_SA
#undef PG8_SB
#undef PG8_STAGE
#undef PG8_LDA
#undef PG8_LDB
#undef PG8_MMA
#undef PG8_WAIT_V
#undef PG8_WAIT_L
#undef PG8_BAR
#undef PG8_SCHED
}
}
using pg8::Unit;
typedef f32x4 Acc[2][2][4][2];

DI void rope8(f32x4& v0, f32x4& v1, const f32x2* rp) {
    const f32x4 c01 = *(const f32x4*)rp, c23 = *(const f32x4*)(rp + 2);
    float a, b;
    a = v0[0]; b = v0[1]; v0[0] = a * c01[0] - b * c01[1]; v0[1] = b * c01[0] + a * c01[1];
    a = v0[2]; b = v0[3]; v0[2] = a * c01[2] - b * c01[3]; v0[3] = b * c01[2] + a * c01[3];
    a = v1[0]; b = v1[1]; v1[0] = a * c23[0] - b * c23[1]; v1[1] = b * c23[0] + a * c23[1];
    a = v1[2]; b = v1[3]; v1[2] = a * c23[2] - b * c23[3]; v1[3] = b * c23[2] + a * c23[3];
}
DI u32x4 pack8(const f32x4& v0, const f32x4& v1) { u32x4 w; w.x = pk2(v0[0], v0[1]); w.y = pk2(v0[2], v0[3]); w.z = pk2(v1[0], v1[1]); w.w = pk2(v1[2], v1[3]); return w; }
DI float sigm(float x) { return __builtin_amdgcn_rcpf(1.f + __expf(-x)); }
DI float sigm_pos(float x) { return fmaxf(sigm(x), 1e-30f); }

struct EpiWin {
    static constexpr bool PERM = true, HOOK = false;
    bf16_t *qda, *kda, *qlat, *kvlat, *g, *kr; float *pq, *pkv; const f32x2* rope; int pmoff, pnoff;
    DI void operator()(const Acc& acc, const Unit& u, int wr, int wc, int fr, int fq) const {
        const int pn = u.pn + pnoff, pm = u.pm + pmoff; const int row0 = pm * 256 + wr * 64 + fr; const int cw = wc * 32 + fq * 8; const bool latent = pm < 64;
        if (pn < 6 || pn == 33) {
            if (pn == 33 && wc >= 2) return;
            bf16_t* dst; int ld, colb; float sc;
            if (pn < 3) { dst = qda; ld = 768; colb = pn * 256; sc = QS_DA; } else if (pn < 6) { dst = kda; ld = 768; colb = (pn - 3) * 256; sc = 1.f; } else { dst = kr; ld = 64; colb = 0; sc = 1.f; }
            const int half = wc & 1, jj0 = 4 * fq;
#pragma unroll
            for (int ai = 0; ai < 2; ++ai)
#pragma unroll
                for (int m = 0; m < 4; ++m) {
                    const int row = row0 + ai * 128 + m * 16; const int t = row & 4095; const int pos = half ? (t & 63) : (t >> 6);
                    const f32x2* rp = rope + pos * 16 + jj0;
#pragma unroll
                    for (int bj = 0; bj < 2; ++bj) {
                        if (pn == 33 && bj == 1) continue;
                        f32x4 v0 = acc[ai][bj][m][0], v1 = acc[ai][bj][m][1];
                        if (latent) rope8(v0, v1, rp);
                        v0 = v0 * sc; v1 = v1 * sc;
                        *(u32x4*)(dst + (size_t)row * ld + colb + bj * 128 + cw) = pack8(v0, v1);
                    }
                }
        } else if (pn < 9) {
            bf16_t* dst; int ld, colb; float* pp; int pst, pof;
            if (pn < 8) { dst = qlat; ld = 512; colb = (pn - 6) * 256; pp = pq; pst = 8; pof = (pn - 6) * 4 + wc; } else { dst = kvlat; ld = 256; colb = 0; pp = pkv; pst = 4; pof = wc; }
#pragma unroll
            for (int ai = 0; ai < 2; ++ai)
#pragma unroll
                for (int m = 0; m < 4; ++m) {
                    const int row = row0 + ai * 128 + m * 16; float s = 0.f;
#pragma unroll
                    for (int bj = 0; bj < 2; ++bj) {
                        const f32x4 v0 = acc[ai][bj][m][0], v1 = acc[ai][bj][m][1];
                        s += (v0[0] * v0[0] + v0[1] * v0[1]) + (v0[2] * v0[2] + v0[3] * v0[3]) + (v1[0] * v1[0] + v1[1] * v1[1]) + (v1[2] * v1[2] + v1[3] * v1[3]);
                        *(u32x4*)(dst + (size_t)row * ld + colb + bj * 128 + cw) = pack8(v0, v1);
                    }
                    s += swz<16>(s); s = half_sum(s);
                    if (fq == 0) pp[(size_t)row * pst + pof] = s;
                }
        } else {
            const int colb = (pn - 9) * 256;
#pragma unroll
            for (int ai = 0; ai < 2; ++ai)
#pragma unroll
                for (int m = 0; m < 4; ++m) {
                    const int row = row0 + ai * 128 + m * 16;
#pragma unroll
                    for (int bj = 0; bj < 2; ++bj) {
                        f32x4 v0 = acc[ai][bj][m][0], v1 = acc[ai][bj][m][1];
#pragma unroll
                        for (int e = 0; e < 4; ++e) { v0[e] = sigm_pos(v0[e]); v1[e] = sigm_pos(v1[e]); }
                        *(u32x4*)(g + (size_t)row * 6144 + colb + bj * 128 + cw) = pack8(v0, v1);
                    }
                }
        }
    }
};
struct EpiWinT {
    static constexpr bool PERM = false, HOOK = false;
    bf16_t *vdat, *hyt, *hytc; int pmoff;
    DI void operator()(const Acc& acc, const Unit& u, int wr, int wc, int fr, int fq) const {
        const int pm = u.pm + pmoff; const bool latent = pm < 64;
#pragma unroll
        for (int ai = 0; ai < 2; ++ai)
#pragma unroll
            for (int m = 0; m < 4; ++m) {
                const int row = pm * 256 + ai * 128 + wr * 64 + m * 16 + fq * 4;
                const int b = latent ? (row >> 12) : ((row - ML) >> 8); const int t = latent ? (row & 4095) : ((row - ML) & 255);
#pragma unroll
                for (int bj = 0; bj < 2; ++bj)
#pragma unroll
                    for (int n = 0; n < 2; ++n) {
                        const int col = u.pn * 256 + bj * 128 + wc * 32 + n * 16 + fr; const f32x4 v = acc[ai][bj][m][n];
                        bf16_t* dst;
                        if (col < 768) dst = vdat + ((size_t)(b * 768 + col) * NKEY + (latent ? 256 + t : t));
                        else dst = latent ? hyt + ((size_t)(b * 1536 + col - 768) * 4096 + t) : hytc + ((size_t)(b * 1536 + col - 768) * 256 + t);
                        u32x2 w; w.x = pk2(v[0], v[1]); w.y = pk2(v[2], v[3]); *(u32x2*)dst = w;
                    }
            }
    }
};
DI float rstd_from(const float* p, int n, float inv) { float s = 0.f; for (int i = 0; i < n; ++i) s += p[i]; return 1.0f / sqrtf(s * inv + EPS); }
struct EpiUq {
    static constexpr bool PERM = true, HOOK = false;
    bf16_t* qm; const float* pq; const f32x2* rope;
    DI void operator()(const Acc& acc, const Unit& u, int wr, int wc, int fr, int fq) const {
        const int row0 = u.pm * 256 + wr * 64 + fr; const bool latent = u.pm < 64;
#pragma unroll
        for (int ai = 0; ai < 2; ++ai)
#pragma unroll
            for (int m = 0; m < 4; ++m) {
                const int row = row0 + ai * 128 + m * 16; const int t = row & 4095;
                const f32x4 q0 = *(const f32x4*)(pq + (size_t)row * 8), q1 = *(const f32x4*)(pq + (size_t)row * 8 + 4);
                const float rs = QS_MLA / sqrtf(((q0[0] + q0[1]) + (q0[2] + q0[3]) + (q1[0] + q1[1]) + (q1[2] + q1[3])) * (1.f / 512.f) + EPS);
#pragma unroll
                for (int bj = 0; bj < 2; ++bj) {
                    const int col = u.pn * 256 + bj * 128 + wc * 32 + fq * 8;
                    if (col >= 1152) continue;
                    const int dd = col % 192;
                    f32x4 v0 = acc[ai][bj][m][0] * rs, v1 = acc[ai][bj][m][1] * rs;
                    if (dd >= 128 && latent) { const int pp = dd - 128; const int pos = (pp >> 5) ? (t & 63) : (t >> 6); rope8(v0, v1, rope + pos * 16 + ((pp & 31) >> 1)); }
                    *(u32x4*)(qm + (size_t)row * 1152 + col) = pack8(v0, v1);
                }
            }
    }
};
struct EpiUkv {
    static constexpr bool PERM = true, HOOK = false;
    bf16_t* kn; const float* pkv;
    DI void operator()(const Acc& acc, const Unit& u, int wr, int wc, int fr, int fq) const {
        const int row0 = u.pm * 256 + wr * 64 + fr;
#pragma unroll
        for (int ai = 0; ai < 2; ++ai)
#pragma unroll
            for (int m = 0; m < 4; ++m) {
                const int row = row0 + ai * 128 + m * 16;
                const f32x4 q0 = *(const f32x4*)(pkv + (size_t)row * 4);
                const float rs = 1.0f / sqrtf(((q0[0] + q0[1]) + (q0[2] + q0[3])) * (1.f / 256.f) + EPS);
#pragma unroll
                for (int bj = 0; bj < 2; ++bj) {
                    const int col = u.pn * 256 + bj * 128 + wc * 32 + fq * 8;
                    *(u32x4*)(kn + (size_t)row * 768 + col) = pack8(acc[ai][bj][m][0] * rs, acc[ai][bj][m][1] * rs);
                }
            }
    }
};
struct EpiUkvT {
    static constexpr bool PERM = false, HOOK = false;
    bf16_t* vbt; const float* pkv;
    DI void operator()(const Acc& acc, const Unit& u, int wr, int wc, int fr, int fq) const {
        const bool latent = u.pm < 64;
#pragma unroll
        for (int ai = 0; ai < 2; ++ai)
#pragma unroll
            for (int m = 0; m < 4; ++m) {
                const int row = u.pm * 256 + ai * 128 + wr * 64 + m * 16 + fq * 4;
                const int b = latent ? (row >> 12) : ((row - ML) >> 8); const int key = latent ? 256 + (row & 4095) : ((row - ML) & 255);
                float rs[4];
#pragma unroll
                for (int j = 0; j < 4; ++j) { const f32x4 q0 = *(const f32x4*)(pkv + (size_t)(row + j) * 4); rs[j] = 1.0f / sqrtf(((q0[0] + q0[1]) + (q0[2] + q0[3])) * (1.f / 256.f) + EPS); }
#pragma unroll
                for (int bj = 0; bj < 2; ++bj)
#pragma unroll
                    for (int n = 0; n < 2; ++n) {
                        const int col = u.pn * 256 + bj * 128 + wc * 32 + n * 16 + fr; const f32x4 v = acc[ai][bj][m][n];
                        u32x2 w; w.x = pk2(v[0] * rs[0], v[1] * rs[1]); w.y = pk2(v[2] * rs[2], v[3] * rs[3]);
                        *(u32x2*)(vbt + ((size_t)(b * 768 + col) * NKEY + key)) = w;
                    }
            }
    }
};
struct EpiMerge {
    static constexpr bool PERM = true, HOOK = true;
    const bf16_t* g; bf16_t* o;
    DI void hook(Acc& acc, const Unit& u, int t, int wr, int wc, int fr, int fq) const {
        const int jp = (t == 12) ? 0 : 2048; const int row0 = u.pm * 256 + wr * 64 + fr;
#pragma unroll
        for (int ai = 0; ai < 2; ++ai)
#pragma unroll
            for (int m = 0; m < 4; ++m) {
#pragma unroll
                for (int bj = 0; bj < 2; ++bj) {
                    const bf16_t* p = g + (size_t)(row0 + ai * 128 + m * 16) * 6144 + jp + u.pn * 256 + bj * 128 + wc * 32 + fq * 8;
                    const u32x4 gp = *(const u32x4*)p, gn = *(const u32x4*)(p + 2048);
#pragma unroll
                    for (int e = 0; e < 4; ++e) {
                        const unsigned a_ = gp[e], b_ = gn[e];
                        const float r0 = bflo(a_) * __builtin_amdgcn_rcpf(bflo(b_)), r1 = bfhi(a_) * __builtin_amdgcn_rcpf(bfhi(b_));
                        if (e < 2) { acc[ai][bj][m][0][2 * e] *= r0; acc[ai][bj][m][0][2 * e + 1] *= r1; }
                        else { acc[ai][bj][m][1][2 * (e - 2)] *= r0; acc[ai][bj][m][1][2 * (e - 2) + 1] *= r1; }
                    }
                }
                __builtin_amdgcn_sched_barrier(0);
            }
    }
    DI void operator()(const Acc& acc, const Unit& u, int wr, int wc, int fr, int fq) const {
        const int row0 = u.pm * 256 + wr * 64 + fr;
#pragma unroll
        for (int ai = 0; ai < 2; ++ai)
#pragma unroll
            for (int m = 0; m < 4; ++m) {
                const int row = row0 + ai * 128 + m * 16;
#pragma unroll
                for (int bj = 0; bj < 2; ++bj) {
                    const int col = u.pn * 256 + bj * 128 + wc * 32 + fq * 8;
                    const u32x4 gv = *(const u32x4*)(g + (size_t)row * 6144 + 4096 + col); const f32x4 a0 = acc[ai][bj][m][0], a1 = acc[ai][bj][m][1];
                    u32x4 w; w.x = pk2(bflo(gv.x) * a0[0], bfhi(gv.x) * a0[1]); w.y = pk2(bflo(gv.y) * a0[2], bfhi(gv.y) * a0[3]);
                    w.z = pk2(bflo(gv.z) * a1[0], bfhi(gv.z) * a1[1]); w.w = pk2(bflo(gv.w) * a1[2], bfhi(gv.w) * a1[3]);
                    *(u32x4*)(o + (size_t)row * D + col) = w;
                }
            }
    }
};
struct EpiResid {
    static constexpr bool PERM = false, HOOK = false;
    const float *xinL, *xinC; float *xoutL, *xoutC; const float* mod; int goff; int pmoff;
    const float *stats, *lng, *lnb;
    DI void operator()(const Acc& acc, const Unit& u, int wr, int wc, int fr, int fq) const {
        const int pm = u.pm + pmoff; const bool latent = pm < 64;
        const float* xin = latent ? xinL : xinC - (size_t)ML * D; float* xout = latent ? xoutL : xoutC - (size_t)ML * D;
        const float* gate = mod + (size_t)(latent ? (pm >> 4) : 4) * 12288 + goff;
        const int row0 = pm * 256 + wr * 64 + fr;
#pragma unroll
        for (int bj = 0; bj < 2; ++bj)
#pragma unroll
            for (int n = 0; n < 2; ++n) {
                const int col = u.pn * 256 + bj * 128 + wc * 32 + n * 16 + fq * 4; const f32x4 gv = *(const f32x4*)(gate + col);
                f32x4 lg = (f32x4){1.f, 1.f, 1.f, 1.f}, lb = (f32x4){0.f, 0.f, 0.f, 0.f};
                if (stats) { lg = *(const f32x4*)(lng + col); lb = *(const f32x4*)(lnb + col); }
#pragma unroll
                for (int ai = 0; ai < 2; ++ai)
#pragma unroll
                    for (int m = 0; m < 4; ++m) {
                        const int row = row0 + ai * 128 + m * 16; const size_t off = (size_t)row * D + col;
                        f32x4 xv = *(const f32x4*)(xin + off);
                        if (stats) { const f32x2 st = *(const f32x2*)(stats + (size_t)row * 2); xv = (xv - st.x) * st.y * lg + lb; }
                        *(f32x4*)(xout + off) = xv * ALPHA + gv * acc[ai][bj][m][n];
                    }
            }
    }
};
DI float dpp_ror1(float v) { return __int_as_float(__builtin_amdgcn_mov_dpp(__float_as_int(v), 0x121, 0xf, 0xf, false)); }
DI float dpp_ror15(float v) { return __int_as_float(__builtin_amdgcn_mov_dpp(__float_as_int(v), 0x12f, 0xf, 0xf, false)); }
struct EpiFfnUp {
    static constexpr bool PERM = true, HOOK = false;
    bf16_t *hh, *sa, *sv; const float *fw, *fb;
    DI void operator()(const Acc& acc, const Unit& u, int wr, int wc, int fr, int fq) const {
        const int ch0 = u.pn * 128 + wc * 32 + fq * 8;
        const f32x4 w0a = *(const f32x4*)(fw + ch0), w0b = *(const f32x4*)(fw + ch0 + 4), w1a = *(const f32x4*)(fw + DFF + ch0), w1b = *(const f32x4*)(fw + DFF + ch0 + 4),
                    w2a = *(const f32x4*)(fw + 2 * DFF + ch0), w2b = *(const f32x4*)(fw + 2 * DFF + ch0 + 4), ba = *(const f32x4*)(fb + ch0), bb = *(const f32x4*)(fb + ch0 + 4);
#pragma unroll
        for (int ai = 0; ai < 2; ++ai)
#pragma unroll
            for (int m = 0; m < 4; ++m) {
                const int row = u.pm * 256 + ai * 128 + wr * 64 + m * 16 + fr;
                const f32x4 c0 = acc[ai][0][m][0], c1 = acc[ai][0][m][1], v0 = acc[ai][1][m][0], v1 = acc[ai][1][m][1];
                f32x4 p0, p1, n0, n1;
#pragma unroll
                for (int e = 0; e < 4; ++e) {
                    const float pc0 = dpp_ror1(c0[e]), pc1 = dpp_ror1(c1[e]), nc0 = dpp_ror15(c0[e]), nc1 = dpp_ror15(c1[e]);
                    const float pp0 = m > 0 ? dpp_ror1(acc[ai][0][m > 0 ? m - 1 : 0][0][e]) : pc0, pp1 = m > 0 ? dpp_ror1(acc[ai][0][m > 0 ? m - 1 : 0][1][e]) : pc1;
                    const float nn0 = m < 3 ? dpp_ror15(acc[ai][0][m < 3 ? m + 1 : 3][0][e]) : nc0, nn1 = m < 3 ? dpp_ror15(acc[ai][0][m < 3 ? m + 1 : 3][1][e]) : nc1;
                    p0[e] = fr == 0 ? pp0 : pc0; p1[e] = fr == 0 ? pp1 : pc1; n0[e] = fr == 15 ? nn0 : nc0; n1[e] = fr == 15 ? nn1 : nc1;
                }
                f32x4 x0 = p0 * w0a + c0 * w1a + n0 * w2a + ba, x1 = p1 * w0b + c1 * w1b + n1 * w2b + bb;
#pragma unroll
                for (int e = 0; e < 4; ++e) { x0[e] = x0[e] * sigm(x0[e]) * v0[e]; x1[e] = x1[e] * sigm(x1[e]) * v1[e]; }
                *(u32x4*)(hh + (size_t)row * DFF + ch0) = pack8(x0, x1);
                const int r64 = row & 63;
                if (r64 < 2 || r64 >= 62) {
                    *(u32x4*)(sa + (size_t)((row >> 6) * 4 + (r64 < 2 ? r64 : r64 - 60)) * DFF + ch0) = pack8(c0, c1);
                    if (r64 == 0 || r64 == 63) *(u32x4*)(sv + (size_t)((row >> 6) * 2 + (r64 ? 1 : 0)) * DFF + ch0) = pack8(v0, v1);
                }
            }
    }
};
struct EpiResidAtomic {
    static constexpr bool PERM = false, HOOK = false;
    float* xout; const float* gate;
    DI void operator()(const Acc& acc, const Unit& u, int wr, int wc, int fr, int fq) const {
        const int row0 = u.pm * 256 + wr * 64 + fr;
#pragma unroll
        for (int bj = 0; bj < 2; ++bj)
#pragma unroll
            for (int n = 0; n < 2; ++n) {
                const int col = u.pn * 256 + bj * 128 + wc * 32 + n * 16 + fq * 4; const f32x4 gv = *(const f32x4*)(gate + col);
#pragma unroll
                for (int ai = 0; ai < 2; ++ai)
#pragma unroll
                    for (int m = 0; m < 4; ++m) *(f32x4*)(xout + (size_t)(row0 + ai * 128 + m * 16) * D + col) = gv * acc[ai][bj][m][n];
            }
    }
};
struct EpiPlain {
    static constexpr bool PERM = true, HOOK = false;
    bf16_t* o; int ld;
    DI void operator()(const Acc& acc, const Unit& u, int wr, int wc, int fr, int fq) const {
        const int row0 = u.pm * 256 + wr * 64 + fr;
#pragma unroll
        for (int ai = 0; ai < 2; ++ai)
#pragma unroll
            for (int m = 0; m < 4; ++m)
#pragma unroll
                for (int bj = 0; bj < 2; ++bj)
                    *(u32x4*)(o + (size_t)(row0 + ai * 128 + m * 16) * ld + u.pn * 256 + bj * 128 + wc * 32 + fq * 8) = pack8(acc[ai][bj][m][0], acc[ai][bj][m][1]);
    }
};

DI int src_col(int kind, int n0, bool& perm) {
    perm = false;
    switch (kind) {
    case 1:
        if (n0 < 1536) { const int base = n0 < 768 ? 0 : 768; const int n1 = n0 < 768 ? n0 : n0 - 768; perm = true;
            return base + ((n1 >> 6) & 1) * 384 + (n1 >> 7) * 64 + ((n1 >> 5) & 1) * 32; }
        if (n0 < 2048) return 2304 + (n0 - 1536);
        if (n0 < 2304) return 2816 + (n0 - 2048);
        if (n0 < 8448) return 4672 + (n0 - 2304);
        if (n0 < 8512) { perm = true; return 3072 + (n0 - 8448); }
        return -1;
    case 2:
        return n0 < 768 ? 1536 + n0 : 3136 + (n0 - 768);
    case 3:
        if (n0 >= 1152) return -1;
        perm = (n0 % 192) >= 128; return n0;
    case 6: return ((n0 >> 7) & 1) * DFF + (n0 >> 8) * 128 + (n0 & 127);
    case 4: return (n0 >> 7) * 256 + (n0 & 127);
    case 5: return (n0 >> 7) * 256 + 128 + (n0 & 127);
    default: return n0;
    }
}
DI void tr_item(const float* W, int K, int Nsrc, bf16_t* WT, int ntile, int kind, const float* kscale, int item, LAS float* scr, int lane, int ldw) {
    const int kb = item / ntile, nb = item % ntile, k0 = 64 * kb, n0 = 32 * nb;
    bool perm; const int sc = src_col(kind, n0, perm);
    const int c = lane & 7;
    if (sc < 0) {
        unsigned zz = 0u; asm volatile("" : "+v"(zz));
#pragma unroll
        for (int j = 0; j < 4; ++j) { const int n = (lane >> 3) + 8 * j; *(u32x4*)(WT + (size_t)(n0 + n) * ldw + k0 + 8 * c) = (u32x4){zz, zz, zz, zz}; }
        return;
    }
#pragma unroll
    for (int i = 0; i < 32; ++i) { const int kk = 2 * i + (lane >> 5); float v = __builtin_nontemporal_load(&W[(size_t)(k0 + kk) * Nsrc + sc + (lane & 31)]); if (kscale) v *= kscale[k0 + kk]; scr[kk * 33 + (lane & 31)] = v; }
    LDS_WAIT();
#pragma unroll
    for (int j = 0; j < 4; ++j) { const int n = (lane >> 3) + 8 * j; const int ns = perm ? ((n & 1) * 16 + (n >> 1)) : n; const LAS float* s = scr + (8 * c) * 33 + ns;
        u32x4 o; o.x = pk2(s[0 * 33], s[1 * 33]); o.y = pk2(s[2 * 33], s[3 * 33]); o.z = pk2(s[4 * 33], s[5 * 33]); o.w = pk2(s[6 * 33], s[7 * 33]);
        *(u32x4*)(WT + (size_t)(n0 + n) * ldw + k0 + 8 * c) = o; }
    LDS_WAIT();
}
DI void convert_weights(const Args& a, int layer, LAS unsigned char* lds, int gw_in, int NGW, int wid_in, int lane_in) {
    int lane = lane_in, gw = gw_in, wid = wid_in; asm volatile("" : "+v"(lane), "+s"(gw), "+s"(wid));
    LAS float* scr = (LAS float*)(lds + wid * 8704);
    constexpr int C0 = 32 * 272, C1 = C0 + 32 * 72, C2 = C1 + 8 * 40, C3 = C2 + 4 * 24, C4 = C3 + 4 * 24, C5 = C4 + 12 * 64, C6 = C5 + 12 * 64, C7 = C6 + 8 * 64, C8 = C7 + 32 * 64,
                  C9 = C8 + 32 * 352, C10 = C9 + 88 * 64;
    for (int it = gw; it < C10; it += NGW) {
        const float* W; int K, Ns, nt, kind, item, ldw = 0; bf16_t* WT; const float* ksc = nullptr;
        if (it < C0) { W = ARG(I_WIN) + (size_t)layer * D * 10816; K = D; Ns = 10816; WT = (bf16_t*)(WSP() + O_WIN); nt = 272; kind = 1; item = it; }
        else if (it < C1) { W = ARG(I_WIN) + (size_t)layer * D * 10816; K = D; Ns = 10816; WT = (bf16_t*)(WSP() + O_WINT); nt = 72; kind = 2; item = it - C0; }
        else if (it < C2) { W = ARG(I_WUQ) + (size_t)layer * 512 * 1152; K = 512; Ns = 1152; WT = (bf16_t*)(WSP() + O_WUQ); nt = 40; kind = 3; item = it - C1; ksc = ARG(I_QG) + layer * 512; }
        else if (it < C3) { W = ARG(I_WUKV) + (size_t)layer * 256 * 1536; K = 256; Ns = 1536; WT = (bf16_t*)(WSP() + O_WUKV); nt = 24; kind = 4; item = it - C2; ksc = ARG(I_KVG) + layer * 256; }
        else if (it < C4) { W = ARG(I_WUKV) + (size_t)layer * 256 * 1536; K = 256; Ns = 1536; WT = (bf16_t*)(WSP() + O_WUKVT); nt = 24; kind = 5; item = it - C3; ksc = ARG(I_KVG) + layer * 256; }
        else if (it < C5) { W = ARG(I_WBA) + (size_t)layer * 768 * D; K = 768; Ns = D; WT = (bf16_t*)(WSP() + O_WBA); nt = 64; kind = 0; item = it - C4; ldw = 2048; }
        else if (it < C6) { W = ARG(I_WBB) + (size_t)layer * 768 * D; K = 768; Ns = D; WT = (bf16_t*)(WSP() + O_WBA) + 768; nt = 64; kind = 0; item = it - C5; ldw = 2048; }
        else if (it < C7) { W = ARG(I_WBC) + (size_t)layer * 512 * D; K = 512; Ns = D; WT = (bf16_t*)(WSP() + O_WBA) + 1536; nt = 64; kind = 0; item = it - C6; ldw = 2048; }
        else if (it < C8) { W = ARG(I_WOUT) + (size_t)layer * D * D; K = D; Ns = D; WT = (bf16_t*)(WSP() + O_WOUT); nt = 64; kind = 0; item = it - C7; }
        else if (it < C9) { W = ARG(I_WUP) + (size_t)layer * D * 11264; K = D; Ns = 11264; WT = (bf16_t*)(WSP() + O_WUP); nt = 352; kind = 6; item = it - C8; }
        else { W = ARG(I_WDN) + (size_t)layer * DFF * D; K = DFF; Ns = D; WT = (bf16_t*)(WSP() + O_WDN); nt = 64; kind = 0; item = it - C9; }
        tr_item(W, K, Ns, WT, nt, kind, ksc, item, scr, lane, ldw ? ldw : K);
    }
}

DI void ln_stats(const f32x4 (&v)[8], float& mean, float& rstd) {
    float s = 0.f;
#pragma unroll
    for (int j = 0; j < 8; ++j) s += (v[j][0] + v[j][1]) + (v[j][2] + v[j][3]);
    mean = wave_sum(s) * (1.f / D); float s2 = 0.f;
#pragma unroll
    for (int j = 0; j < 8; ++j) { const f32x4 d = v[j] - mean; s2 += (d[0] * d[0] + d[1] * d[1]) + (d[2] * d[2] + d[3] * d[3]); }
    rstd = 1.0f / sqrtf(wave_sum(s2) * (1.f / D) + EPS);
}
DI void ln_row(const float* xin, float* xo, const float* g, const float* bt, bf16_t* ao, const float* sh, const float* sc, int lane_in, const float* parts = nullptr, float* stats_out = nullptr) {
    int lane = lane_in; asm volatile("" : "+v"(lane));
    f32x4 v[8];
#pragma unroll
    for (int j = 0; j < 8; ++j) v[j] = *(const f32x4*)(xin + 256 * j + 4 * lane);
    if (parts) {
#pragma unroll
        for (int j = 0; j < 8; ++j) { const float* p = parts + 256 * j + 4 * lane;
            v[j] = v[j] * ALPHA + ((*(const f32x4*)p + *(const f32x4*)(p + (size_t)MC * D)) + (*(const f32x4*)(p + (size_t)2 * MC * D) + *(const f32x4*)(p + (size_t)3 * MC * D))); }
    }
    float mean, rstd;
    if (g) {
        ln_stats(v, mean, rstd);
        if (stats_out && lane == 0) *(f32x2*)stats_out = (f32x2){mean, rstd};
#pragma unroll
        for (int j = 0; j < 8; ++j) { const f32x4 gv = *(const f32x4*)(g + 256 * j + 4 * lane), bv = *(const f32x4*)(bt + 256 * j + 4 * lane); v[j] = (v[j] - mean) * rstd * gv + bv; }
        if (xo) {
#pragma unroll
            for (int j = 0; j < 8; ++j) *(f32x4*)(xo + 256 * j + 4 * lane) = v[j];
        }
    }
    if (ao) {
        ln_stats(v, mean, rstd);
#pragma unroll
        for (int j = 0; j < 8; ++j) { const f32x4 sv = *(const f32x4*)(sc + 256 * j + 4 * lane), hv = *(const f32x4*)(sh + 256 * j + 4 * lane);
            const f32x4 y = (v[j] - mean) * rstd * (sv + 1.0f) + hv; u32x2 w; w.x = pk2(y[0], y[1]); w.y = pk2(y[2], y[3]); *(u32x2*)(ao + 256 * j + 4 * lane) = w; }
    }
}

DI int crow(int r, int hi) { return (r & 3) + 8 * (r >> 2) + 4 * hi; }
#define MFMA32(a, b, c) __builtin_amdgcn_mfma_f32_32x32x16_bf16((a), (b), (c), 0, 0, 0)

template <int MODE>
DI void attn_unit(LAS unsigned char* lds, const bf16_t* Q, int ldq, const bf16_t* K1, const bf16_t* K2, const bf16_t* VT, bf16_t* O,
                  int b, int h, int qrow0, bool ctxstream, float lam, float outscale, const float* subg, int wid_s) {
    constexpr int KD = MODE ? 192 : 128, KS = KD * 2 + 16, KCH = KD / 8, KPT = 64 * KCH / 512;
    constexpr int KBYTES = 64 * KS, VS = 144, VBYTES = 128 * VS, BUF = KBYTES + VBYTES;
    constexpr int ND0 = MODE ? 12 : 4, NMAP = MODE ? 1 : 2;
    const int tid_ = tid_fresh(wid_s);
    const int tid = tid_, lane = tid & 63, wid = tid >> 6, r32 = lane & 31, hi = lane >> 5;
    const int nkt = ctxstream ? 4 : 68;
    LAS float* wsf = (LAS float*)(lds + 2 * BUF) + wid * 64;
    bf16x8 qf[MODE ? NMAP * ND0 : 1];
    LAS unsigned char* qlds = lds + 2 * BUF + 2048 + wid * (32 * 272);
    {
        const bf16_t* qp = Q + (size_t)(qrow0 + wid * 32 + r32) * ldq + h * KD + 8 * hi;
#pragma unroll
        for (int i = 0; i < NMAP * ND0; ++i) { const bf16x8 qv = *(const bf16x8*)(qp + 16 * i);
            if (MODE) qf[MODE ? i : 0] = qv; else *(LAS bf16x8*)(qlds + r32 * 272 + i * 32 + hi * 16) = qv; }
        LDS_WAIT();
    }
    const unsigned ko = (unsigned)((tid >> 4) * 768 + (tid & 15) * 8);
    const unsigned kd = (unsigned)((tid >> 4) * KS + (tid & 15) * 16);
    const unsigned ko2 = (unsigned)((tid >> 3) * 64 + (tid & 7) * 8), kd2 = (unsigned)((tid >> 3) * KS + 256 + (tid & 7) * 16);
    const unsigned vo = (unsigned)((tid >> 3) * NKEY + (tid & 7) * 8), vd = (unsigned)(KBYTES + (tid >> 3) * VS + (tid & 7) * 16);
    const bf16_t* vbase = VT + (size_t)(b * 768 + h * 128) * NKEY;
    u32x4 kreg[KPT], vreg[2];
#define ATT_LOAD(kt) do { const int krow_ = (kt) < 4 ? ML + b * 256 + (kt) * 64 : b * 4096 + ((kt) - 4) * 64; \
        const bf16_t* kb_ = K1 + (size_t)krow_ * 768 + h * 128; \
        kreg[0] = *(const u32x4*)(kb_ + ko); kreg[1] = *(const u32x4*)(kb_ + 32 * 768 + ko); \
        if (MODE) kreg[KPT - 1] = *(const u32x4*)(K2 + (size_t)krow_ * 64 + ko2); \
        const bf16_t* vb_ = vbase + (kt) * 64; \
        vreg[0] = *(const u32x4*)(vb_ + vo); vreg[1] = *(const u32x4*)(vb_ + (size_t)64 * NKEY + vo); } while (0)
#define ATT_STORE(bufp) do { *(LAS u32x4*)((bufp) + kd) = kreg[0]; *(LAS u32x4*)((bufp) + 32 * KS + kd) = kreg[1]; \
        if (MODE) *(LAS u32x4*)((bufp) + kd2) = kreg[KPT - 1]; \
        *(LAS u32x4*)((bufp) + vd) = vreg[0]; *(LAS u32x4*)((bufp) + 64 * VS + vd) = vreg[1]; } while (0)
    float mrun[NMAP], lrun[NMAP]; f32x16 oacc[NMAP][4];
#pragma unroll
    for (int s = 0; s < NMAP; ++s) { mrun[s] = -1e30f; lrun[s] = 0.f;
#pragma unroll
        for (int nb = 0; nb < 4; ++nb)
#pragma unroll
            for (int r = 0; r < 16; ++r) oacc[s][nb][r] = 0.f; }
    const int sig = (r32 & ~12) | ((r32 & 4) << 1) | ((r32 & 8) >> 1);
    const int kfrag = sig * KS + hi * 16, vfrag = KBYTES + r32 * VS + hi * 16;
    ATT_LOAD(0); ATT_STORE(lds); __syncthreads();
#pragma unroll
    for (int s = 0; s < NMAP; ++s) {
        float mx = -1e30f;
#pragma unroll
        for (int mf = 0; mf < 2; ++mf) {
            f32x16 p0;
#pragma unroll
            for (int r = 0; r < 16; ++r) p0[r] = 0.f;
#pragma unroll
            for (int d0 = 0; d0 < ND0; ++d0) {
                const bf16x8 a0 = *(const LAS bf16x8*)(lds + kfrag + mf * 32 * KS + (s * 4 + d0) * 32);
                const bf16x8 qv = MODE ? qf[MODE ? s * 4 + d0 : 0] : *(const LAS bf16x8*)(qlds + r32 * 272 + (s * 4 + d0) * 32 + hi * 16);
                p0 = MFMA32(a0, qv, p0);
            }
#pragma unroll
            for (int r = 0; r < 16; ++r) mx = fmaxf(mx, p0[r]);
        }
        mrun[s] = half_max(mx);
    }
    for (int kt = 0; kt < nkt; ++kt) {
        LAS unsigned char* buf = lds + (kt & 1) * BUF;
        if (kt + 1 < nkt) ATT_LOAD(kt + 1);
        constexpr int NBLK = ND0 / 4;
        bf16x8 kf[2][4], vfA[4], vfB[4];
#define ATT_LOADK(dst, s_, mf_, blk_) do { _Pragma("unroll") for (int d_ = 0; d_ < 4; ++d_) dst[d_] = *(const LAS bf16x8*)(buf + kfrag + (mf_) * 32 * KS + ((s_) * 4 + (blk_) * 4 + d_) * 32); } while (0)
        if constexpr (MODE == 0) {
#pragma unroll
            for (int mf = 0; mf < 2; ++mf) {
                f32x16 pp[2];
#pragma unroll
                for (int s = 0; s < 2; ++s) {
                    bf16x8 qb[4];
                    ATT_LOADK(kf[0], s, mf, 0);
#pragma unroll
                    for (int d = 0; d < 4; ++d) qb[d] = *(const LAS bf16x8*)(qlds + r32 * 272 + (s * 4 + d) * 32 + hi * 16);
#pragma unroll
                    for (int r = 0; r < 16; ++r) pp[s][r] = 0.f;
                    __builtin_amdgcn_sched_barrier(0);
#pragma unroll
                    for (int d = 0; d < 4; ++d) pp[s] = MFMA32(kf[0][d], qb[d], pp[s]);
                }
#pragma unroll
                for (int nb = 0; nb < 4; ++nb) vfA[nb] = *(const LAS bf16x8*)(buf + vfrag + nb * 32 * VS + (2 * mf) * 32);
                __builtin_amdgcn_sched_barrier(0);
                u32x4 pw[2][2];
#pragma unroll
                for (int s = 0; s < 2; ++s) {
                    float mx = pp[s][0];
#pragma unroll
                    for (int r = 1; r < 16; ++r) mx = fmaxf(mx, pp[s][r]);
                    if (__any(mx > mrun[s] + 64.0f)) {
                        mx = half_max(mx);
                        const float mn = fmaxf(mrun[s], mx); const float alpha = __builtin_amdgcn_exp2f(mrun[s] - mn); mrun[s] = mn; lrun[s] *= alpha;
                        if (hi == 0) wsf[r32] = alpha;
                        LDS_WAIT();
#pragma unroll
                        for (int r = 0; r < 16; ++r) { const float f = wsf[crow(r, hi)];
#pragma unroll
                            for (int nb = 0; nb < 4; ++nb) oacc[s][nb][r] *= f; }
                        LDS_WAIT();
                    }
                    const float mr = mrun[s]; float rs = 0.f;
#pragma unroll
                    for (int r = 0; r < 16; ++r) { pp[s][r] = __builtin_amdgcn_exp2f(pp[s][r] - mr); rs += pp[s][r]; }
                    lrun[s] += rs;
#pragma unroll
                    for (int j = 0; j < 2; ++j)
                        pw[s][j] = (u32x4){pk2(pp[s][8 * j], pp[s][8 * j + 1]), pk2(pp[s][8 * j + 2], pp[s][8 * j + 3]), pk2(pp[s][8 * j + 4], pp[s][8 * j + 5]), pk2(pp[s][8 * j + 6], pp[s][8 * j + 7])};
                }
#pragma unroll
                for (int nb = 0; nb < 4; ++nb) vfB[nb] = *(const LAS bf16x8*)(buf + vfrag + nb * 32 * VS + (2 * mf + 1) * 32);
                __builtin_amdgcn_sched_barrier(0);
#pragma unroll
                for (int nb = 0; nb < 4; ++nb) { oacc[0][nb] = MFMA32(__builtin_bit_cast(bf16x8, pw[0][0]), vfA[nb], oacc[0][nb]); oacc[NMAP - 1][nb] = MFMA32(__builtin_bit_cast(bf16x8, pw[1][0]), vfA[nb], oacc[NMAP - 1][nb]); }
                __builtin_amdgcn_sched_barrier(0);
#pragma unroll
                for (int nb = 0; nb < 4; ++nb) { oacc[0][nb] = MFMA32(__builtin_bit_cast(bf16x8, pw[0][1]), vfB[nb], oacc[0][nb]); oacc[NMAP - 1][nb] = MFMA32(__builtin_bit_cast(bf16x8, pw[1][1]), vfB[nb], oacc[NMAP - 1][nb]); }
            }
        } else {
            f32x16 pp[2];
#pragma unroll
            for (int mf = 0; mf < 2; ++mf)
#pragma unroll
                for (int r = 0; r < 16; ++r) pp[mf][r] = 0.f;
            ATT_LOADK(kf[0], 0, 0, 0);
#pragma unroll
            for (int q = 0; q < 6; ++q) {
                if (q + 1 < 6) ATT_LOADK(kf[(q + 1) & 1], 0, (q + 1) / 3, (q + 1) % 3);
                __builtin_amdgcn_sched_barrier(0);
#pragma unroll
                for (int d = 0; d < 4; ++d) pp[q / 3] = MFMA32(kf[q & 1][d], qf[MODE ? (q % 3) * 4 + d : 0], pp[q / 3]);
            }
#pragma unroll
            for (int nb = 0; nb < 4; ++nb) vfA[nb] = *(const LAS bf16x8*)(buf + vfrag + nb * 32 * VS);
            __builtin_amdgcn_sched_barrier(0);
            float mx = fmaxf(pp[0][0], pp[1][0]);
#pragma unroll
            for (int r = 1; r < 16; ++r) mx = fmaxf(mx, fmaxf(pp[0][r], pp[1][r]));
            if (__any(mx > mrun[0] + 64.0f)) {
                mx = half_max(mx);
                const float mn = fmaxf(mrun[0], mx); const float alpha = __builtin_amdgcn_exp2f(mrun[0] - mn); mrun[0] = mn; lrun[0] *= alpha;
                if (hi == 0) wsf[r32] = alpha;
                LDS_WAIT();
#pragma unroll
                for (int r = 0; r < 16; ++r) { const float f = wsf[crow(r, hi)];
#pragma unroll
                    for (int nb = 0; nb < 4; ++nb) oacc[0][nb][r] *= f; }
                LDS_WAIT();
            }
            u32x4 pw[4];
            {
                const float mr = mrun[0]; float rs = 0.f;
#pragma unroll
                for (int mf = 0; mf < 2; ++mf) {
#pragma unroll
                    for (int r = 0; r < 16; ++r) { pp[mf][r] = __builtin_amdgcn_exp2f(pp[mf][r] - mr); rs += pp[mf][r]; }
#pragma unroll
                    for (int j = 0; j < 2; ++j)
                        pw[2 * mf + j] = (u32x4){pk2(pp[mf][8 * j], pp[mf][8 * j + 1]), pk2(pp[mf][8 * j + 2], pp[mf][8 * j + 3]), pk2(pp[mf][8 * j + 4], pp[mf][8 * j + 5]), pk2(pp[mf][8 * j + 6], pp[mf][8 * j + 7])};
                }
                lrun[0] += rs;
            }
#pragma unroll
            for (int vb = 0; vb < 4; ++vb) {
                if (vb + 1 < 4) {
                    if (vb & 1) {
#pragma unroll
                        for (int nb = 0; nb < 4; ++nb) vfA[nb] = *(const LAS bf16x8*)(buf + vfrag + nb * 32 * VS + (vb + 1) * 32);
                    } else {
#pragma unroll
                        for (int nb = 0; nb < 4; ++nb) vfB[nb] = *(const LAS bf16x8*)(buf + vfrag + nb * 32 * VS + (vb + 1) * 32);
                    }
                }
                __builtin_amdgcn_sched_barrier(0);
#pragma unroll
                for (int nb = 0; nb < 4; ++nb) oacc[0][nb] = MFMA32(__builtin_bit_cast(bf16x8, pw[vb]), (vb & 1) ? vfB[nb] : vfA[nb], oacc[0][nb]);
            }
        }
#undef ATT_LOADK
        if (kt + 1 < nkt) ATT_STORE(lds + ((kt + 1) & 1) * BUF);
        __syncthreads();
    }
#undef ATT_LOAD
#undef ATT_STORE
    const int orow = qrow0 + wid * 32;
    if (MODE == 0) {
        const float l1 = half_sum(lrun[0]), l2 = half_sum(lrun[NMAP - 1]);
        if (hi == 0) { wsf[r32] = 1.0f / l1; wsf[32 + r32] = lam / l2; }
        LDS_WAIT();
        float ss[16];
#pragma unroll
        for (int r = 0; r < 16; ++r) { const float i1 = wsf[crow(r, hi)], i2 = wsf[32 + crow(r, hi)]; float s = 0.f;
#pragma unroll
            for (int nb = 0; nb < 4; ++nb) { const float o = oacc[0][nb][r] * i1 - oacc[NMAP - 1][nb][r] * i2; oacc[0][nb][r] = o; s += o * o; }
            ss[r] = s; }
#pragma unroll
        for (int r = 0; r < 16; ++r) {
            ss[r] = sum32(ss[r]);
            ss[r] = outscale / sqrtf(ss[r] * (1.f / 128.f) + EPS);
        }
#pragma unroll
        for (int nb = 0; nb < 4; ++nb) { const float gg = subg[nb * 32 + r32];
#pragma unroll
            for (int r = 0; r < 16; ++r) O[(size_t)(orow + crow(r, hi)) * 2048 + h * 128 + nb * 32 + r32] = f2bf(oacc[0][nb][r] * ss[r] * gg); }
        LDS_WAIT();
    } else {
        const float l1 = half_sum(lrun[0]);
        if (hi == 0) wsf[r32] = 1.0f / l1;
        LDS_WAIT();
#pragma unroll
        for (int r = 0; r < 16; ++r) { const float i1 = wsf[crow(r, hi)];
#pragma unroll
            for (int nb = 0; nb < 4; ++nb) O[(size_t)(orow + crow(r, hi)) * 2048 + h * 128 + nb * 32 + r32] = f2bf(oacc[0][nb][r] * i1); }
        LDS_WAIT();
    }
    __syncthreads();
}

DI float conv3(const bf16_t* u, int t, int n, float w0, float w1, float w2, float bias) {
    float acc = bf2f(u[t]) * w1 + bias;
    if (t > 0) acc += bf2f(u[t - 1]) * w0;
    if (t < n - 1) acc += bf2f(u[t + 1]) * w2;
    return acc;
}
DI int zaddr(int bb, int t) { return bb * 8576 + (t >> 8) * 528 + (t & 255) * 2; }
DI void hyena_unit(LAS unsigned char* lds, const Args& a, int layer, bool isctx, int c, int bp, const bf16_t* Rf, const bf16_t* uT, bf16_t* Oc, int wid_s) {
    const int n = isctx ? 256 : 4096, NT1 = n >> 8;
    LAS unsigned char* cp = lds; LAS unsigned char* Z = lds + 131072;
    const int tid_ = tid_fresh(wid_s);
    const int tid = tid_, lane = tid & 63, wid = tid >> 6, r32 = lane & 31, hi = lane >> 5, t1 = r32 >> 1, bb = r32 & 1, b = 2 * bp + bb;
    const float* cw = ARG(I_HCW) + (size_t)layer * 3 * 1536; const float* cb = ARG(I_HCB) + (size_t)layer * 1536;
    {
        const float w0 = cw[c], w1 = cw[1536 + c], w2 = cw[3072 + c], bs = cb[c];
#pragma unroll 4
        for (int e = tid; e < 2 * n; e += 512) { const int b_ = e / n, t = e % n;
            *(LAS bf16_t*)(Z + zaddr(b_, t)) = f2bf(conv3(uT + ((size_t)((2 * bp + b_) * 1536 + c)) * n, t, n, w0, w1, w2, bs)); }
    }
#pragma unroll 1
    for (int order = 0; order < 2; ++order) {
        const bf16_t* R = Rf + (size_t)(order * 512 + c) * (2 * n);
        for (int g = tid_fresh(wid_s); g < 1024; g += 512) { const int X8 = g * 8; const int B = n - 4096 + X8;
            u32x4 lo = (u32x4){0u, 0u, 0u, 0u}, hh = lo;
            if (B >= 0 && B < 2 * n) lo = *(const u32x4*)(R + B);
            if (B + 8 >= 0 && B + 8 < 2 * n) hh = *(const u32x4*)(R + B + 8);
            const unsigned w[8] = {lo.x, lo.y, lo.z, lo.w, hh.x, hh.y, hh.z, hh.w};
#pragma unroll
            for (int cc = 0; cc < 8; ++cc) { const int sft = 7 - cc; u32x4 o;
                if ((sft & 1) == 0) o = (u32x4){w[sft / 2], w[sft / 2 + 1], w[sft / 2 + 2], w[sft / 2 + 3]};
                else o = (u32x4){__builtin_amdgcn_alignbit(w[sft / 2 + 1], w[sft / 2], 16), __builtin_amdgcn_alignbit(w[sft / 2 + 2], w[sft / 2 + 1], 16),
                                 __builtin_amdgcn_alignbit(w[sft / 2 + 3], w[sft / 2 + 2], 16), __builtin_amdgcn_alignbit(w[sft / 2 + 4], w[sft / 2 + 3], 16)};
                *(LAS u32x4*)(cp + cc * 16384 + X8 * 2) = o; }
        }
        __syncthreads();
        f32x16 acc[8];
#pragma unroll
        for (int cc = 0; cc < 8; ++cc)
#pragma unroll
            for (int r = 0; r < 16; ++r) acc[cc][r] = 0.f;
        {
            const int d0 = -15 + 4 * wid, d1 = (wid == 7) ? 16 : d0 + 4;
#pragma unroll 1
            for (int d = d0; d < d1; ++d) {
                const int s1 = t1 - d; const bool valid = (s1 >= 0) && (s1 < 16);
                const LAS unsigned char* ab = cp + (4088 - 256 * d - 8 * r32 + 8 * hi) * 2;
                const LAS unsigned char* zb = Z + bb * 8576 + (valid ? s1 : 0) * 528 + hi * 16;
                bf16x8 Bc = *(const LAS bf16x8*)(zb), Bn = Bc, Aa[4], Ab[4];
#pragma unroll
                for (int c4 = 0; c4 < 4; ++c4) Aa[c4] = *(const LAS bf16x8*)(ab + c4 * 16384);
                if (!valid) Bc = (bf16x8){0, 0, 0, 0, 0, 0, 0, 0};
#pragma unroll 1
                for (int kk = 0; kk < 16; ++kk) {
#pragma unroll
                    for (int c4 = 0; c4 < 4; ++c4) Ab[c4] = *(const LAS bf16x8*)(ab + (4 + c4) * 16384 + kk * 32);
                    __builtin_amdgcn_sched_barrier(0);
#pragma unroll
                    for (int c4 = 0; c4 < 4; ++c4) acc[c4] = MFMA32(Aa[c4], Bc, acc[c4]);
                    const int kn = kk < 15 ? kk + 1 : 15;
                    Bn = *(const LAS bf16x8*)(zb + kn * 32);
#pragma unroll
                    for (int c4 = 0; c4 < 4; ++c4) Aa[c4] = *(const LAS bf16x8*)(ab + c4 * 16384 + kn * 32);
                    __builtin_amdgcn_sched_barrier(0);
#pragma unroll
                    for (int c4 = 0; c4 < 4; ++c4) acc[4 + c4] = MFMA32(Ab[c4], Bc, acc[4 + c4]);
                    if (!valid) Bn = (bf16x8){0, 0, 0, 0, 0, 0, 0, 0};
                    Bc = Bn;
                }
            }
        }
        __syncthreads();
        f32x16 yv;
#pragma unroll
        for (int half = 0; half < 2; ++half) {
            LAS float* xs = (LAS float*)cp;
#pragma unroll
            for (int c = 0; c < 4; ++c)
#pragma unroll
                for (int r = 0; r < 16; ++r) xs[((c * 8 + wid) * 16 + r) * 64 + lane] = acc[half * 4 + c][r];
            __syncthreads();
            if ((wid >> 2) == half) {
                const int c = wid & 3;
#pragma unroll
                for (int r = 0; r < 16; ++r) { float sm = 0.f;
#pragma unroll
                    for (int v = 0; v < 8; ++v) sm += xs[((c * 8 + v) * 16 + r) * 64 + lane];
                    yv[r] = sm; __builtin_amdgcn_sched_barrier(0); }
            }
            __syncthreads();
        }
        __syncthreads();
        {
            const int g_tid = tid_fresh(wid_s), g_lane = g_tid & 63, wid = g_tid >> 6, r32 = g_lane & 31, hi = g_lane >> 5, t1 = r32 >> 1, bb = r32 & 1, b = 2 * bp + bb;
            const int part = order ? 1024 : 512;
            const float w0 = cw[part + c], w1 = cw[1536 + part + c], w2 = cw[3072 + part + c], bs = cb[part + c];
            const float skip = ARG(I_HSKIP)[(size_t)layer * 1024 + order * 512 + c];
            const bf16_t* ug = uT + ((size_t)(b * 1536 + part + c)) * n;
            int wv = wid; asm volatile("" : "+v"(wv));
#pragma unroll
            for (int r = 0; r < 16; ++r) {
                const int t = 256 * t1 + 8 * crow(r, hi) + wv;
                const float zold = bf2f(*(const LAS bf16_t*)(Z + zaddr(bb, t)));
                const float gate = conv3(ug, t, n, w0, w1, w2, bs);
                const float zn = gate * (yv[r] + skip * zold);
                if (order == 0) *(LAS bf16_t*)(Z + zaddr(bb, t)) = f2bf(zn);
                else Oc[(size_t)(isctx ? ML + b * 256 + t : b * 4096 + t) * 2048 + c] = f2bf(zn);
            }
        }
        __syncthreads();
    }
}

DI void hyena_ctx_unit(LAS unsigned char* lds, int layer, int c, int bp, const bf16_t* Rf, const bf16_t* uT, bf16_t* Oc, int wid_s) {
    const int tid = tid_fresh(wid_s), b_ = tid >> 8, t = tid & 255, b = 2 * bp + b_;
    LAS float* zf = (LAS float*)lds; LAS float* rf = (LAS float*)(lds + 2048);
    const float* cw = ARG(I_HCW) + (size_t)layer * 3 * 1536; const float* cb = ARG(I_HCB) + (size_t)layer * 1536;
    float z = conv3(uT + (size_t)(b * 1536 + c) * 256, t, 256, cw[c], cw[1536 + c], cw[3072 + c], cb[c]);
#pragma unroll 1
    for (int order = 0; order < 2; ++order) {
        zf[b_ * 256 + t] = z; rf[tid] = bf2f(Rf[(size_t)(order * 512 + c) * 512 + tid]);
        __syncthreads();
        float y = 0.f; const LAS float* rp = rf + (255 - t); const LAS float* zp = zf + b_ * 256;
#pragma unroll 8
        for (int s2 = 0; s2 < 256; ++s2) y += rp[s2] * zp[s2];
        const int part = order ? 1024 : 512;
        const float gate = conv3(uT + (size_t)(b * 1536 + part + c) * 256, t, 256, cw[part + c], cw[1536 + part + c], cw[3072 + part + c], cb[part + c]);
        z = gate * (y + ARG(I_HSKIP)[(size_t)layer * 1024 + order * 512 + c] * z);
        __syncthreads();
    }
    Oc[(size_t)(ML + b * 256 + t) * 2048 + c] = f2bf(z);
}

#define XB_TMO      128
#define XB_XCNT(j)  (256  + 64 * (j))
#define XB_XSUB(j)  (1280 + 64 * (j))
#define XB_XGEN(j)  (2304 + 64 * (j))
#define XB_TOP      3328
#define XB_TOPGEN   3392
#define XB_SPIN_CAP (1u << 18)
DI unsigned xb_ld(unsigned* p) { return __hip_atomic_load(p, __ATOMIC_RELAXED, __HIP_MEMORY_SCOPE_AGENT); }
DI unsigned xb_add(unsigned* p, unsigned v) { return __hip_atomic_fetch_add(p, v, __ATOMIC_RELAXED, __HIP_MEMORY_SCOPE_AGENT); }
DI unsigned xb_xcc_id() { return (unsigned)__builtin_amdgcn_s_getreg((3 << 11) | 20) & 0xFu; }
#define XB_SPIN(cond, bar) do { unsigned _sp = 0; while (cond) { __builtin_amdgcn_s_sleep(1); \
    if ((++_sp & 255u) == 0u) { if (xb_ld(&(bar)[XB_TMO])) break; if (_sp > XB_SPIN_CAP) { atomicAdd(&(bar)[XB_TMO], 1u); break; } } } } while (0)
DI void xcd_barrier_complete(unsigned* bar, unsigned x, unsigned& nloc, unsigned& nx) {
    const unsigned G = gridDim.x * gridDim.y * gridDim.z;
    unsigned sum, cnt, mine, sp = 0u;
    for (;;) {
        sum = 0u; cnt = 0u; mine = 0u;
#pragma unroll
        for (unsigned j = 0; j < 16; ++j) { const unsigned c = xb_ld(&bar[XB_XCNT(j)]); sum += c; cnt += (c > 0u) ? 1u : 0u; mine = (j == x) ? c : mine; }
        if (sum == G) break;
        __builtin_amdgcn_s_sleep(1);
        if ((++sp & 255u) == 0u) { if (xb_ld(&bar[XB_TMO])) break; if (sp > XB_SPIN_CAP) { atomicAdd(&bar[XB_TMO], 1u); break; } }
    }
    nloc = mine > 0u ? mine : 1u; nx = cnt > 0u ? cnt : 1u;
}
DI void xcd_barrier(unsigned* bar, volatile LAS unsigned* st) {
    asm volatile("s_waitcnt vmcnt(0)" ::: "memory");
    __syncthreads();
    if (threadIdx.x == 0) {
        const unsigned x = xb_xcc_id();
        __builtin_amdgcn_s_waitcnt(0);
        unsigned nloc = st[0], nx = st[1];
        if (nloc == 0u) { xcd_barrier_complete(bar, x, nloc, nx); st[0] = nloc; st[1] = nx; }
        const unsigned old = xb_add(&bar[XB_XSUB(x)], 1u);
        const unsigned gen = old / nloc;
        if (old + 1u == (gen + 1u) * nloc) {
            __builtin_amdgcn_fence(__ATOMIC_RELEASE, "agent");
            asm volatile("s_waitcnt vmcnt(0)" ::: "memory");
            const unsigned og = xb_add(&bar[XB_TOP], 1u);
            const unsigned tg = og / nx;
            if (og + 1u == (tg + 1u) * nx) xb_add(&bar[XB_TOPGEN], 1u);
            else XB_SPIN(xb_ld(&bar[XB_TOPGEN]) == tg, bar);
            __builtin_amdgcn_fence(__ATOMIC_ACQUIRE, "agent");
            xb_add(&bar[XB_XGEN(x)], 1u);
            asm volatile("s_waitcnt vmcnt(0)" ::: "memory");
        } else {
            XB_SPIN(xb_ld(&bar[XB_XGEN(x)]) == gen, bar);
            __builtin_amdgcn_fence(__ATOMIC_ACQUIRE, "agent");
            asm volatile("s_waitcnt vmcnt(0)" ::: "memory");
        }
    }
    __syncthreads();
}
#define GBAR() xcd_barrier((unsigned*)(WSP() + O_BAR), (volatile LAS unsigned*)(lds + LDS_BYTES - 16))

__global__ void __launch_bounds__(512) fwd_kernel(Args a) {
    extern __shared__ __attribute__((aligned(16))) unsigned char smem[];
    LAS unsigned char* lds = (LAS unsigned char*)smem;
    const int wid = wave_id(), G = gridDim.x, bid = blockIdx.x;
    const int gw = bid * 8 + wid, NGW = G * 8;
    { unsigned* barw = (unsigned*)(WSP() + O_BAR) + XB_XCNT(xb_xcc_id());
      if (threadIdx.x == 0) { volatile LAS unsigned* st = (volatile LAS unsigned*)(lds + LDS_BYTES - 16); st[0] = 0u; st[1] = 0u;
        (void)xb_add(barw, 1u); } }
    __syncthreads();
    float* modb = (float*)(WSP() + O_MOD); float* lamb = (float*)(WSP() + O_LAM); f32x2* ropeb = (f32x2*)(WSP() + O_ROPE); float* hsum = (float*)(WSP() + O_HSUM);
    float* pq = (float*)(WSP() + O_PQ); float* pkv = (float*)(WSP() + O_PKV);
    float* xc = (float*)(WSP() + O_XC);
    bf16_t* Abuf = (bf16_t*)(WSP() + O_A);

    {
        const int tid = tid_fresh(wid), lane = tid & 63;
        LAS float* sc = (LAS float*)lds;
        if (bid < 384) {
            for (int e = tid; e < 5 * 2048; e += 512) { const int r = e >> 11, k = e & 2047; const float v = r < 4 ? ARG(I_C)[r * 2048 + k] : ARG(I_CCTX)[k]; sc[e] = v / (1.f + __expf(-v)); }
            __syncthreads();
            LAS float* red = (LAS float*)(lds + 40960);
            for (int it = bid; it < 384; it += G) {
                const int layer = it / 192, cgp = it % 192, j = tid & 63, kg = tid >> 6, col = cgp * 64 + j;
                const float* W = ARG(I_ADAW) + (size_t)layer * D * 12288 + col;
                float ac[5] = {0.f, 0.f, 0.f, 0.f, 0.f};
#pragma unroll 16
                for (int k = kg * 256; k < kg * 256 + 256; ++k) { const float w = __builtin_nontemporal_load(&W[(size_t)k * 12288]);
#pragma unroll
                    for (int r = 0; r < 5; ++r) ac[r] += sc[r * 2048 + k] * w; }
#pragma unroll
                for (int r = 0; r < 5; ++r) red[(kg * 5 + r) * 64 + j] = ac[r];
                __syncthreads();
                if (tid < 320) { const int r = tid >> 6; float s = 0.f;
#pragma unroll
                    for (int q = 0; q < 8; ++q) s += red[(q * 5 + r) * 64 + j];
                    modb[(size_t)(layer * 5 + r) * 12288 + col] = s + ARG(I_ADAB)[layer * 12288 + col]; }
                __syncthreads();
            }
        }
        __syncthreads();
        {
            LAS float* feat = (LAS float*)lds;
            LAS float* hA = (LAS float*)(lds + 2048);
            LAS float* hB = (LAS float*)(lds + 4096);
            for (int it = bid; it < 1056; it += G) {
                const int set = it < 512 ? 0 : (it < 1024 ? 1 : 2); const int layer = set == 1 ? 1 : 0; const int n = set == 2 ? 256 : 4096;
                const int t0 = (set == 0 ? it : (set == 1 ? it - 512 : it - 1024)) * 8;
                float* H = (float*)(WSP() + O_HTMP) + (size_t)(set == 0 ? 0 : (set == 1 ? 4096 : 8192)) * 2048;
                const float* w1 = ARG(I_HW1) + layer * 33 * 64; const float* b1 = ARG(I_HB1) + layer * 64;
                const float* w2 = ARG(I_HW2) + layer * 4096;   const float* b2 = ARG(I_HB2) + layer * 64;
                const float* w3 = ARG(I_HW3) + layer * 4096;   const float* b3 = ARG(I_HB3) + layer * 64;
                const float* w4 = ARG(I_HW4) + (size_t)layer * 64 * 2048; const float* fr_ = ARG(I_HFREQ) + layer * 64;
                if (tid < 8 * 33) { const int tt = tid / 33, k = tid % 33; const int t = t0 + tt; float v;
                    if (k == 0) v = (float)t / (float)(n - 1);
                    else { const int bnd = (k - 1) & 15; const float band = 1e-4f + (float)bnd * ((15.0f - 1e-4f) / 15.0f); const float ph = ((float)(6.283185307179586 / n) * (float)t) * band;
                        v = k <= 16 ? cosf(ph) : -sinf(ph); }
                    feat[tt * 40 + k] = v; }
                __syncthreads();
                const int tt = tid >> 6, j = tid & 63; const float fq_ = fr_[j];
                { float s = b1[j]; for (int k = 0; k < 33; ++k) s += feat[tt * 40 + k] * w1[k * 64 + j]; hA[tt * 64 + j] = sinf(fq_ * s); }
                __syncthreads();
                { float s = b2[j]; for (int k = 0; k < 64; ++k) s += hA[tt * 64 + k] * w2[k * 64 + j]; hB[tt * 64 + j] = sinf(fq_ * s); }
                __syncthreads();
                { float s = b3[j]; for (int k = 0; k < 64; ++k) s += hB[tt * 64 + k] * w3[k * 64 + j]; hA[tt * 64 + j] = sinf(fq_ * s); }
                __syncthreads();
#pragma unroll 1
                for (int q = 0; q < 4; ++q) {
                    const int jj = tid + 512 * q; float o[8] = {0.f, 0.f, 0.f, 0.f, 0.f, 0.f, 0.f, 0.f};
#pragma unroll 1
                    for (int k0 = 0; k0 < 64; k0 += 16) {
                        float w[16];
#pragma unroll
                        for (int kk = 0; kk < 16; ++kk) w[kk] = w4[(k0 + kk) * 2048 + jj];
#pragma unroll
                        for (int kk = 0; kk < 16; ++kk)
#pragma unroll
                            for (int x = 0; x < 8; ++x) o[x] += hA[x * 64 + k0 + kk] * w[kk];
                    }
                    const int ch = jj & 511, dir = (jj >> 9) & 1;
                    const float delta = fabsf(-3.0701134573253946f + (float)ch * ((-15.350567286626973f + 3.0701134573253946f) / 511.0f));
                    float asum = 0.f;
#pragma unroll
                    for (int x = 0; x < 8; ++x) { const int t = t0 + x; const float tl = (float)t / (float)(n - 1); const float v = o[x] * expf(-tl * delta);
                        H[(size_t)t * 2048 + jj] = v; if (dir == 0 || t <= n - 2) asum += fabsf(v); }
                    atomicAdd(hsum + set * 2048 + jj, asum);
                }
                __syncthreads();
            }
        }
        if (bid == G - 1) {
            if (tid < 2) {
                const float* dl = ARG(I_LAMBDA) + tid * 256; float s1 = 0.f, s2 = 0.f;
                for (int k = 0; k < 64; ++k) { s1 += dl[k] * dl[64 + k]; s2 += dl[128 + k] * dl[192 + k]; }
                const float li = 0.8f - 0.6f * expf(-0.3f * (float)tid);
                lamb[tid * 2] = expf(s1) - expf(s2) + li; lamb[tid * 2 + 1] = li;
            }
            for (int e = tid; e < 1024; e += 512) { const int pos = e >> 4, jj = e & 15; const float inv = powf(10000.0f, -(float)jj / 16.0f); const float ang = (float)pos * inv;
                ropeb[e] = (f32x2){cosf(ang), sinf(ang)}; }
        }
        __syncthreads();
        convert_weights(a, 0, lds, gw, NGW, wid, lane);
    }
    cg::this_grid().sync();
    {
        const int tid = tid_fresh(wid), lane = tid & 63;
        for (int it = bid; it < 2 * 1024 + 2 * 1024 + 2 * 64; it += G) {
            int set, r = it; if (r < 2048) set = 0; else if (r < 4096) { set = 1; r -= 2048; } else { set = 2; r -= 4096; }
            const int n = set == 2 ? 256 : 4096; const int ng = 2 * n / 8; const int o = r / ng, xg = r % ng;
            const float* H = (const float*)(WSP() + O_HTMP) + (size_t)(set == 0 ? 0 : (set == 1 ? 4096 : 8192)) * 2048;
            bf16_t* Rb = (bf16_t*)(WSP() + (set == 0 ? O_FILT0 : (set == 1 ? O_FILT1 : O_FILTC)));
            const int c = tid; const float nrm = 1.0f / (hsum[set * 2048 + o * 1024 + c] + hsum[set * 2048 + o * 1024 + 512 + c]);
            float v[8];
#pragma unroll
            for (int i = 0; i < 8; ++i) { const int x = xg * 8 + i; const int dl = (n - 1) - x;
                v[i] = dl >= 0 ? H[(size_t)dl * 2048 + o * 1024 + c] * nrm : (dl > -n ? H[(size_t)(-dl - 1) * 2048 + o * 1024 + 512 + c] * nrm : 0.f); }
            *(u32x4*)(Rb + (size_t)(o * 512 + c) * (2 * n) + xg * 8) = (u32x4){pk2(v[0], v[1]), pk2(v[2], v[3]), pk2(v[4], v[5]), pk2(v[6], v[7])};
        }
        for (int row = gw; row < MT; row += NGW) {
            const float* xin = row < ML ? ARG(I_X) + (size_t)row * D : ARG(I_CTX) + (size_t)(row - ML) * D;
            const float* md = modb + (size_t)(row < ML ? (row >> 12) : 4) * 12288;
            ln_row(xin, nullptr, nullptr, nullptr, Abuf + (size_t)row * D, md, md + 2048, lane);
        }
    }
    GBAR();

#pragma unroll 1
    for (int layer = 0; layer < 2; ++layer) {
        const float* modl = modb + (size_t)layer * 5 * 12288;
        const int MU = layer == 0 ? MT : ML;
        {
            const int nq = layer == 0 ? 1 : 4;
#pragma unroll 1
            for (int q = 0; q < nq; ++q) {
                int M_ = MT, N_ = NWIN, pmo = 0, pno = 0, cix = bid; size_t aoff = 0, boff = 0;
                if (layer != 0) {
                    if (q == 0) { M_ = ML; }
                    else { M_ = MC; pmo = 64; aoff = (size_t)ML * D; pno = q == 1 ? 3 : (q == 2 ? 8 : 33); N_ = q == 1 ? 768 : 256; boff = (size_t)pno * 256 * D; cix = (bid - (q == 1 ? 192 : (q == 2 ? 204 : 208)) + G) % G; }
                }
                EpiWin E{(bf16_t*)(WSP() + O_QDA), (bf16_t*)(WSP() + O_KDA), (bf16_t*)(WSP() + O_QLAT), (bf16_t*)(WSP() + O_KVLAT), (bf16_t*)(WSP() + O_G), (bf16_t*)(WSP() + O_KR), pq, pkv, ropeb, pmo, pno};
                pg8::Gemm g{Abuf + aoff, (const bf16_t*)(WSP() + O_WIN) + boff, M_, N_, D};
                pg8::gemm_phase<EpiWin, false>(lds, g, G, cix, E, wid);
            }
            const int nt_ = layer == 0 ? 1 : 2;
#pragma unroll 1
            for (int q = 0; q < nt_; ++q) {
                int M_ = MT, N_ = NWINT, pmo = 0, cix = (bid + G - 8) % G; size_t aoff = 0;
                if (layer != 0) {
                    if (q == 0) { M_ = ML; cix = (bid + G - 128) % G; }
                    else { M_ = MC; N_ = 768; pmo = 64; aoff = (size_t)ML * D; cix = (bid - 212 + G) % G; }
                }
                EpiWinT ET{(bf16_t*)(WSP() + O_VDAT), (bf16_t*)(WSP() + O_HYT), (bf16_t*)(WSP() + O_HYTC), pmo};
                pg8::Gemm gt{Abuf + aoff, (const bf16_t*)(WSP() + O_WINT), M_, N_, D};
                pg8::gemm_phase<EpiWinT, true>(lds, gt, G, cix, ET, wid);
            }
        }
        GBAR();
        {
            EpiUq E1{(bf16_t*)(WSP() + O_QM), pq, ropeb};
            pg8::Gemm g1{(const bf16_t*)(WSP() + O_QLAT), (const bf16_t*)(WSP() + O_WUQ), MU, NUQ, 512};
            pg8::gemm_phase<EpiUq, false>(lds, g1, G, bid, E1, wid);
            EpiUkv E2{(bf16_t*)(WSP() + O_KN), pkv};
            pg8::Gemm g2{(const bf16_t*)(WSP() + O_KVLAT), (const bf16_t*)(WSP() + O_WUKV), MT, 768, 256};
            pg8::gemm_phase<EpiUkv, false>(lds, g2, G, (bid + 88) % G, E2, wid);
            EpiUkvT E3{(bf16_t*)(WSP() + O_VBT), pkv};
            pg8::Gemm g3{(const bf16_t*)(WSP() + O_KVLAT), (const bf16_t*)(WSP() + O_WUKVT), MT, 768, 256};
            pg8::gemm_phase<EpiUkvT, true>(lds, g3, G, (bid + 40) % G, E3, wid);
        }
        GBAR();
        {
            if (wid >= 4) __builtin_amdgcn_s_setprio(1);
            const float lam = __uint_as_float(__builtin_amdgcn_readfirstlane(__float_as_uint(lamb[layer * 2]))), lam_init = __uint_as_float(__builtin_amdgcn_readfirstlane(__float_as_uint(lamb[layer * 2 + 1])));
            const int nctx = layer == 0 ? 24 : 0; const int NA = 768 + 2 * nctx;
            int bid_l = (G % 8 == 0) ? (bid % 8) * (G / 8) + bid / 8 : bid;
            asm volatile("" : "+s"(bid_l));
            for (int u = bid_l; u < NA; u += G) {
                int mode, idx; bool cs;
                if (u < 384) { mode = 0; idx = u; cs = false; } else if (u < 768) { mode = 1; idx = u - 384; cs = false; } else if (u < 768 + nctx) { mode = 0; idx = u - 768; cs = true; } else { mode = 1; idx = u - 768 - nctx; cs = true; }
                int b, h, qrow0;
                if (!cs) { const int bh = idx >> 4, qb = idx & 15; b = bh / 6; h = bh % 6; qrow0 = b * 4096 + qb * 256; } else { b = idx / 6; h = idx % 6; qrow0 = ML + b * 256; }
                if (mode == 0) attn_unit<0>(lds, (const bf16_t*)(WSP() + O_QDA), 768, (const bf16_t*)(WSP() + O_KDA), nullptr, (const bf16_t*)(WSP() + O_VDAT), (bf16_t*)(WSP() + O_OA), b, h, qrow0, cs, lam, 1.0f - lam_init, ARG(I_SUBG) + layer * 128, wid);
                else attn_unit<1>(lds, (const bf16_t*)(WSP() + O_QM), 1152, (const bf16_t*)(WSP() + O_KN), (const bf16_t*)(WSP() + O_KR), (const bf16_t*)(WSP() + O_VBT), (bf16_t*)(WSP() + O_OA) + 768, b, h, qrow0, cs, 0.f, 1.f, nullptr, wid);
            }
            const int NH = layer == 0 ? 2048 : 1024;
            for (int u = bid_l; u < NH; u += G) {
                const bool cs = u >= 1024; const int idx = cs ? u - 1024 : u; const int c = idx >> 1, bp = idx & 1;
                if (cs) hyena_ctx_unit(lds, layer, c, bp, (const bf16_t*)(WSP() + O_FILTC), (const bf16_t*)(WSP() + O_HYTC), (bf16_t*)(WSP() + O_OA) + 1536, wid);
                else hyena_unit(lds, a, layer, false, c, bp, (const bf16_t*)(WSP() + (layer == 0 ? O_FILT0 : O_FILT1)), (const bf16_t*)(WSP() + O_HYT), (bf16_t*)(WSP() + O_OA) + 1536, wid);
            }
        }
        __builtin_amdgcn_s_setprio(0);
        GBAR();
        {
            EpiMerge E{(const bf16_t*)(WSP() + O_G), Abuf};
            pg8::Gemm g{(const bf16_t*)(WSP() + O_OA), (const bf16_t*)(WSP() + O_WBA), MU, D, D};
            pg8::gemm_phase<EpiMerge, false>(lds, g, G, bid, E, wid);
        }
        GBAR();
        {
            EpiResid E{layer == 0 ? ARG(I_X) : AOUT(), layer == 0 ? ARG(I_CTX) : xc, AOUT(), xc, modl, 2 * 2048, 0,
                       layer == 0 ? nullptr : (const float*)(WSP() + O_ST2), ARG(I_LN2G), ARG(I_LN2B)};
            pg8::Gemm g{Abuf, (const bf16_t*)(WSP() + O_WOUT), ML, D, D};
            pg8::gemm_phase<EpiResid, false>(lds, g, G, bid, E, wid);
            if (layer == 0) {
#pragma unroll 1
                for (int ks = 0; ks < 4; ++ks) {
                    EpiResidAtomic Ea{(float*)(WSP() + O_QM) + (size_t)ks * MC * D, modl + (size_t)4 * 12288 + 2 * 2048};
                    pg8::Gemm gs{Abuf + (size_t)ML * D + ks * 512, (const bf16_t*)(WSP() + O_WOUT) + ks * 512, MC, D, 512, D};
                    pg8::gemm_phase<EpiResidAtomic, false>(lds, gs, G, (bid - 32 * ks + G) % G, Ea, wid);
                }
            }
        }
        GBAR();
        for (int row = gw; row < MU; row += NGW) {
            float* xr = row < ML ? AOUT() + (size_t)row * D : xc + (size_t)(row - ML) * D;
            const float* md = modl + (size_t)(row < ML ? (row >> 12) : 4) * 12288;
            const bool cx = row >= ML;
            ln_row(cx ? ARG(I_CTX) + (size_t)(row - ML) * D : xr, cx ? xr : nullptr, ARG(I_LN1G) + layer * D, ARG(I_LN1B) + layer * D, Abuf + (size_t)row * D, md + 3 * 2048, md + 4 * 2048, lane_id(),
                   cx ? (const float*)(WSP() + O_QM) + (size_t)(row - ML) * D : nullptr, cx ? nullptr : (float*)(WSP() + O_ST1) + (size_t)row * 2);
        }
        GBAR();
        {
            bf16_t* HH = (bf16_t*)(WSP() + O_HH);
            const float* fw = ARG(I_FCW) + (size_t)layer * 3 * DFF; const float* fb = ARG(I_FCB) + (size_t)layer * DFF;
            {
                EpiFfnUp E{HH, (bf16_t*)(WSP() + O_SA), (bf16_t*)(WSP() + O_SV), fw, fb};
                pg8::Gemm g{Abuf, (const bf16_t*)(WSP() + O_WUP), MU, 11264, D};
                pg8::gemm_phase<EpiFfnUp, false>(lds, g, G, bid, E, wid);
            }
            GBAR();
            {
                const bf16_t* SA = (const bf16_t*)(WSP() + O_SA); const bf16_t* SV = (const bf16_t*)(WSP() + O_SV);
                int tl = tid_fresh(wid), bid_l = bid; asm volatile("" : "+s"(bid_l));
                for (int e = bid_l * 512 + tl; e < (MU / 32) * 704; e += G * 512) {
                    const int ri = e / 704, c8 = (e % 704) * 8; const int blk = ri >> 1, last = ri & 1; const int row = blk * 64 + (last ? 63 : 0);
                    const int seqlen = row < ML ? 4096 : 256; const int pos = (row < ML ? row : row - ML) & (seqlen - 1);
                    const bf16_t* pa; const bf16_t* ca; const bf16_t* na; float m0 = 1.f, m2 = 1.f;
                    if (!last) { ca = SA + (size_t)(blk * 4 + 0) * DFF; na = SA + (size_t)(blk * 4 + 1) * DFF; pa = pos > 0 ? SA + (size_t)((blk - 1) * 4 + 3) * DFF : ca; m0 = pos > 0 ? 1.f : 0.f; }
                    else { pa = SA + (size_t)(blk * 4 + 2) * DFF; ca = SA + (size_t)(blk * 4 + 3) * DFF; na = pos < seqlen - 1 ? SA + (size_t)((blk + 1) * 4 + 0) * DFF : ca; m2 = pos < seqlen - 1 ? 1.f : 0.f; }
                    const u32x4 a0 = *(const u32x4*)(pa + c8), a1 = *(const u32x4*)(ca + c8), a2 = *(const u32x4*)(na + c8), vv = *(const u32x4*)(SV + (size_t)ri * DFF + c8);
                    float o[8];
#pragma unroll
                    for (int i = 0; i < 4; ++i) {
                        const unsigned w0 = a0[i], w1 = a1[i], w2 = a2[i], wv = vv[i]; const int ch = c8 + 2 * i;
                        float x = bflo(w0) * (m0 * fw[ch]) + bflo(w1) * fw[DFF + ch] + bflo(w2) * (m2 * fw[2 * DFF + ch]) + fb[ch];
                        o[2 * i] = x * sigm(x) * bflo(wv);
                        x = bfhi(w0) * (m0 * fw[ch + 1]) + bfhi(w1) * fw[DFF + ch + 1] + bfhi(w2) * (m2 * fw[2 * DFF + ch + 1]) + fb[ch + 1];
                        o[2 * i + 1] = x * sigm(x) * bfhi(wv);
                    }
                    *(u32x4*)(HH + (size_t)row * DFF + c8) = (u32x4){pk2(o[0], o[1]), pk2(o[2], o[3]), pk2(o[4], o[5]), pk2(o[6], o[7])};
                }
            }
            GBAR();
            {
                EpiResid E{AOUT(), xc, AOUT(), xc, modl, 5 * 2048, 0, (const float*)(WSP() + O_ST1), ARG(I_LN1G) + layer * D, ARG(I_LN1B) + layer * D};
                pg8::Gemm g{HH, (const bf16_t*)(WSP() + O_WDN), ML, D, DFF};
                pg8::gemm_phase<EpiResid, false>(lds, g, G, bid, E, wid);
                if (layer == 0) {
#pragma unroll 1
                    for (int ks = 0; ks < 4; ++ks) {
                        EpiResidAtomic Ea{(float*)(WSP() + O_QM) + (size_t)ks * MC * D, modl + (size_t)4 * 12288 + 5 * 2048};
                        pg8::Gemm gs{HH + (size_t)ML * DFF + ks * 1408, (const bf16_t*)(WSP() + O_WDN) + ks * 1408, MC, D, 1408, DFF};
                        pg8::gemm_phase<EpiResidAtomic, false>(lds, gs, G, (bid - 32 * ks + G) % G, Ea, wid);
                    }
                }
            }
            GBAR();
        }
        {
            const float* modn = modb + (size_t)5 * 12288;
            for (int row = gw; row < MU; row += NGW) {
                float* xr = row < ML ? AOUT() + (size_t)row * D : xc + (size_t)(row - ML) * D;
                const float* md = modn + (size_t)(row < ML ? (row >> 12) : 4) * 12288;
                const bool keep = (layer == 0 && row < ML);
                ln_row(xr, keep ? nullptr : xr, ARG(I_LN2G) + layer * D, ARG(I_LN2B) + layer * D, layer == 0 ? Abuf + (size_t)row * D : nullptr, md, md + 2048, lane_id(),
                       row >= ML ? (const float*)(WSP() + O_QM) + (size_t)(row - ML) * D : nullptr, keep ? (float*)(WSP() + O_ST2) + (size_t)row * 2 : nullptr);
            }
            if (layer == 0) { __syncthreads(); convert_weights(a, 1, lds, gw, NGW, wid, lane_id()); GBAR(); }
        }
    }
}

extern "C" void kernel_launch(void* const* d_in, const int* in_sizes, int n_in, void* d_out, int out_size, void* d_ws, size_t ws_size, hipStream_t stream) {
    static int grid = 0;
    if (grid == 0) {
        if (n_in != 36 || ws_size < WS_END) { fprintf(stderr, "kernel_launch: n_in %d ws %zu (need %zu)\n", n_in, ws_size, (size_t)WS_END); grid = -1; return; }
        int dev = 0, cus = 0, per_cu = 0;
        hipGetDevice(&dev);
        hipDeviceGetAttribute(&cus, hipDeviceAttributeMultiprocessorCount, dev);
        hipFuncSetAttribute((const void*)fwd_kernel, hipFuncAttributeMaxDynamicSharedMemorySize, LDS_BYTES);
        hipOccupancyMaxActiveBlocksPerMultiprocessor(&per_cu, (const void*)fwd_kernel, 512, LDS_BYTES);
        if (per_cu < 1) per_cu = 1;
        grid = cus * 1;
        (void)hipGetLastError();
    }
    if (grid < 0) return;
    hipMemsetAsync(d_ws, 0, ZERO_BYTES, stream);
    Args a{};
    for (int i = 0; i < 36; ++i) a.in[i] = (const float*)d_in[i];
    a.out = (float*)d_out; a.ws = (unsigned char*)d_ws;
    void* args[] = {&a};
    hipError_t e = hipLaunchCooperativeKernel((const void*)fwd_kernel, dim3(grid), dim3(512), args, LDS_BYTES, stream);
    if (e != hipSuccess) fprintf(stderr, "cooperative launch failed: %s (grid %d)\n", hipGetErrorString(e), grid);
}
```
